# Optimizing an MI355X kernel written in HIP

```python
import math
import jax, jax.numpy as jnp
from jax import lax
import numpy as np

D_MODEL = 2048
BATCH = 4
SEQ = 4096
DEPTH = 2

HEAD_DIM = 128
WIDTH_A = D_MODEL // 2
WIDTH_B = D_MODEL // 2
N_HEADS_A = WIDTH_A // HEAD_DIM
N_HEADS_B = WIDTH_B // HEAD_DIM
CHUNK = 128
Q_BLOCK = 128
SSM_WIDTH = D_MODEL // 2
SSM_GROUP = 16
SSM_GROUPS = SSM_WIDTH // SSM_GROUP
SSM_STATE = 64
EPS = 1e-6
DT_MIN = 1e-3
DT_MAX = 1e-1

kernel_name = "hybrid_sgu_stickbreak_s5_adaln"


def rms_norm(x, g):
    xf = x.astype(jnp.float32)
    y = xf * lax.rsqrt(jnp.mean(xf * xf, axis=-1, keepdims=True) + EPS)
    return (y * g.astype(jnp.float32)).astype(x.dtype)


def spatial_gating(u, v, norm_g, w_s, b_s):
    bsz, l, _ = v.shape
    n_chunks = l // CHUNK
    vh = v.reshape(bsz, n_chunks, CHUNK, N_HEADS_A, HEAD_DIM)
    vh = rms_norm(vh, norm_g.reshape(N_HEADS_A, HEAD_DIM))
    causal = jnp.tril(jnp.ones((CHUNK, CHUNK), dtype=bool))
    w = jnp.where(causal[None], w_s, 0.0).astype(vh.dtype)
    s = jnp.einsum('hts,bnshd->bnthd', w, vh) + b_s.T.astype(vh.dtype)[None, None, :, :, None]
    return u * s.reshape(bsz, l, WIDTH_A)


def stick_breaking(q, k, v):
    bsz, l, h, dh = q.shape
    n_blocks = l // Q_BLOCK
    qb = q.reshape(bsz, n_blocks, Q_BLOCK, h, dh).transpose(1, 0, 3, 2, 4)
    kt = k.transpose(0, 2, 1, 3)
    vt = v.transpose(0, 2, 1, 3)
    scale = 1.0 / math.sqrt(dh)
    k_pos = jnp.arange(l)

    def block(args):
        q_blk, blk = args
        q_pos = blk * Q_BLOCK + jnp.arange(Q_BLOCK)
        mask = k_pos[None, :] < q_pos[:, None]
        z = jnp.einsum('bhqd,bhkd->bhqk', q_blk, kt).astype(jnp.float32) * scale
        log_beta = jax.nn.log_sigmoid(z)
        log_keep = jnp.where(mask, jax.nn.log_sigmoid(-z), 0.0)
        later = lax.cumsum(log_keep, axis=3, reverse=True) - log_keep
        w = jnp.where(mask, jnp.exp(log_beta + later), 0.0)
        return jnp.einsum('bhqk,bhkd->bhqd', w.astype(vt.dtype), vt)

    out = lax.map(block, (qb, jnp.arange(n_blocks)))
    return out.transpose(1, 0, 3, 2, 4).reshape(bsz, l, h * dh)


def s5_ssm(u, lam_re, lam_im, b_re, b_im, c_re, c_im, d_skip, log_dt):
    f32 = jnp.float32
    bsz, l, _ = u.shape
    uf = u.astype(f32).reshape(bsz, l, SSM_GROUPS, SSM_GROUP)
    dt = jnp.exp(log_dt.astype(f32))[:, None]
    lr = lam_re.astype(f32)
    li = lam_im.astype(f32)
    mag = jnp.exp(lr * dt)
    a_re = mag * jnp.cos(li * dt)
    a_im = mag * jnp.sin(li * dt)
    den = lr * lr + li * li
    nr = a_re - 1.0
    coef_re = (nr * lr + a_im * li) / den
    coef_im = (a_im * lr - nr * li) / den
    br = b_re.astype(f32)
    bi = b_im.astype(f32)
    bb_re = coef_re[..., None] * br - coef_im[..., None] * bi
    bb_im = coef_re[..., None] * bi + coef_im[..., None] * br
    bu_re = jnp.einsum('gpc,blgc->blgp', bb_re, uf)
    bu_im = jnp.einsum('gpc,blgc->blgp', bb_im, uf)
    a_re_t = jnp.broadcast_to(a_re, (1, l) + a_re.shape)
    a_im_t = jnp.broadcast_to(a_im, (1, l) + a_im.shape)

    def combine(e1, e2):
        a1r, a1i, b1r, b1i = e1
        a2r, a2i, b2r, b2i = e2
        return (a2r * a1r - a2i * a1i,
                a2r * a1i + a2i * a1r,
                a2r * b1r - a2i * b1i + b2r,
                a2r * b1i + a2i * b1r + b2i)

    _, _, h_re, h_im = lax.associative_scan(combine, (a_re_t, a_im_t, bu_re, bu_im), axis=1)
    y = (jnp.einsum('gcp,blgp->blgc', c_re.astype(f32), h_re)
         - jnp.einsum('gcp,blgp->blgc', c_im.astype(f32), h_im))
    y = y.reshape(bsz, l, SSM_WIDTH) + d_skip.astype(f32) * u.astype(f32)
    return y.astype(u.dtype)


def ab_mixer(h, w_in, w_out, sgu_norm_g, sgu_w, sgu_b):
    bsz, l, _ = h.shape
    proj = h @ w_in
    cuts = np.cumsum([WIDTH_A, WIDTH_A, WIDTH_A, WIDTH_B, WIDTH_B, WIDTH_B]).tolist()
    a_u, a_v, a_z, q, k, v, b_z = jnp.split(proj, cuts, axis=-1)
    out_a = spatial_gating(jax.nn.gelu(a_u), jax.nn.gelu(a_v), sgu_norm_g, sgu_w, sgu_b)
    out_a = out_a * jax.nn.silu(a_z)
    shp = (bsz, l, N_HEADS_B, HEAD_DIM)
    out_b = stick_breaking(q.reshape(shp), k.reshape(shp), v.reshape(shp)) * jax.nn.silu(b_z)
    return jnp.concatenate([out_a, out_b], axis=-1) @ w_out


def ssm_mixer(h, w_in, w_out, lam_re, lam_im, b_re, b_im, c_re, c_im, d_skip, log_dt, w_glu, b_glu):
    proj = h @ w_in
    u, z = jnp.split(proj, 2, axis=-1)
    y = s5_ssm(u, lam_re, lam_im, b_re, b_im, c_re, c_im, d_skip, log_dt)
    g = jax.nn.gelu(y)
    y = g * jax.nn.sigmoid(g @ w_glu + b_glu)
    return (y * jax.nn.silu(z)) @ w_out


def setup_inputs(seed: int = 0) -> dict:
    key = jax.random.key(seed)
    ks = jax.random.split(key, 24)
    n_even = (DEPTH + 1) // 2
    n_odd = DEPTH // 2
    d = D_MODEL
    nrm = jax.random.normal
    w_in_ab_cols = 3 * WIDTH_A + 4 * WIDTH_B
    log_dt = jax.random.uniform(ks[20], (n_odd, SSM_GROUPS), minval=math.log(DT_MIN), maxval=math.log(DT_MAX))
    n_idx = jnp.arange(SSM_STATE, dtype=jnp.float32)
    return {
        "x": nrm(ks[0], (BATCH, SEQ, d)),
        "c": nrm(ks[1], (BATCH, d)),
        "ln_pre_g": 1.0 + 0.02 * nrm(ks[2], (DEPTH, d)),
        "ln_post_g": 1.0 + 0.02 * nrm(ks[3], (DEPTH, d)),
        "w_mod": nrm(ks[4], (DEPTH, d, 3 * d)) * d ** -0.5,
        "b_mod": 0.02 * nrm(ks[5], (DEPTH, 3 * d)),
        "w_in_ab": nrm(ks[6], (n_even, d, w_in_ab_cols)) * d ** -0.5,
        "w_out_ab": nrm(ks[7], (n_even, WIDTH_A + WIDTH_B, d)) * (WIDTH_A + WIDTH_B) ** -0.5,
        "sgu_norm_g": 1.0 + 0.02 * nrm(ks[8], (n_even, WIDTH_A)),
        "sgu_w": nrm(ks[9], (n_even, N_HEADS_A, CHUNK, CHUNK)) * CHUNK ** -0.5,
        "sgu_b": 1.0 + 0.02 * nrm(ks[10], (n_even, N_HEADS_A, CHUNK)),
        "w_in_ssm": nrm(ks[11], (n_odd, d, 2 * SSM_WIDTH)) * d ** -0.5,
        "w_out_ssm": nrm(ks[12], (n_odd, SSM_WIDTH, d)) * SSM_WIDTH ** -0.5,
        "lam_re": -0.5 + 0.01 * nrm(ks[13], (n_odd, SSM_GROUPS, SSM_STATE)),
        "lam_im": math.pi * n_idx + 0.01 * nrm(ks[14], (n_odd, SSM_GROUPS, SSM_STATE)),
        "b_re": nrm(ks[15], (n_odd, SSM_GROUPS, SSM_STATE, SSM_GROUP)) * (2 * SSM_GROUP) ** -0.5,
        "b_im": nrm(ks[16], (n_odd, SSM_GROUPS, SSM_STATE, SSM_GROUP)) * (2 * SSM_GROUP) ** -0.5,
        "c_re": nrm(ks[17], (n_odd, SSM_GROUPS, SSM_GROUP, SSM_STATE)) * (2 * SSM_STATE) ** -0.5,
        "c_im": nrm(ks[18], (n_odd, SSM_GROUPS, SSM_GROUP, SSM_STATE)) * (2 * SSM_STATE) ** -0.5,
        "d_skip": nrm(ks[19], (n_odd, SSM_WIDTH)),
        "log_dt": log_dt,
        "w_glu": nrm(ks[21], (n_odd, SSM_WIDTH, SSM_WIDTH)) * SSM_WIDTH ** -0.5,
        "b_glu": 0.02 * nrm(ks[22], (n_odd, SSM_WIDTH)),
    }


def reference(x, c, ln_pre_g, ln_post_g, w_mod, b_mod, w_in_ab, w_out_ab, sgu_norm_g, sgu_w, sgu_b,
              w_in_ssm, w_out_ssm, lam_re, lam_im, b_re, b_im, c_re, c_im, d_skip, log_dt, w_glu, b_glu):
    cond = jax.nn.silu(c)
    for layer in range(DEPTH):
        mod = cond @ w_mod[layer] + b_mod[layer]
        shift, scale, gate = jnp.split(mod[:, None, :], 3, axis=-1)
        h = rms_norm(x, ln_pre_g[layer]) * (1.0 + scale) + shift
        i = layer // 2
        if layer % 2 == 0:
            y = ab_mixer(h, w_in_ab[i], w_out_ab[i], sgu_norm_g[i], sgu_w[i], sgu_b[i])
        else:
            y = ssm_mixer(h, w_in_ssm[i], w_out_ssm[i], lam_re[i], lam_im[i], b_re[i], b_im[i],
                          c_re[i], c_im[i], d_skip[i], log_dt[i], w_glu[i], b_glu[i])
        x = x + (gate * rms_norm(y, ln_post_g[layer])).astype(x.dtype)
    return x
```

```cpp
#include <hip/hip_runtime.h>
#include <hip/hip_cooperative_groups.h>
#include <cstdio>
#include <cstdint>
namespace cg = cooperative_groups;

#ifndef MULTI_LAUNCH
#define MULTI_LAUNCH 1
#endif

namespace pg8 {
#define PG8_LAS __attribute__((address_space(3)))
typedef unsigned short bf16_t;
typedef short bf16x8 __attribute__((ext_vector_type(8)));
typedef float f32x4 __attribute__((ext_vector_type(4)));
typedef unsigned u32x4 __attribute__((ext_vector_type(4)));
constexpr int BM = 256, BK = 64, HALF = 128, HTB = HALF * BK * 2  , STAGE_BYTES = 8 * HTB, NXCD = 8, WGM = 8;

__host__ __device__ __forceinline__ int lds_byte(int r, int c) { const int st = (r >> 4) * 2 + (c >> 5), rr = r & 15, cc = c & 31, ob = rr * 64 + cc * 2; return st * 1024 + (ob ^ (((ob >> 9) & 1) << 5)); }
__host__ __device__ __forceinline__ void stage_rc(int b, int& R, int& C) { const int st = b / 1024, sb = b % 1024, swz = sb ^ (((sb >> 9) & 1) << 5); R = (st >> 1) * 16 + swz / 64; C = (st & 1) * 32 + (swz % 64) / 2; }
__host__ __device__ __forceinline__ int perm32(int rho) { const int n = rho >> 4, i = rho & 15; return 8 * (i >> 2) + 4 * n + (i & 3); }

struct Unit { int pm, pn; };
struct Gemm { const bf16_t* A; const bf16_t* Bt; int M, N, K; };

struct StaticOrder {
    int nM, nN, nwg, G, c;
    __host__ __device__ void init(int M, int N, int G_, int c_) { nM = M / BM; nN = N / BM; nwg = nM * nN; G = G_; c = c_; }
    __host__ __device__ bool next(int i, Unit& u) const {
        const long L = (long)i * G + c; if (L >= nwg) return false;
        int wgid = (int)L; { const int q = nwg / NXCD, r = nwg % NXCD, xcd = wgid % NXCD, off = wgid / NXCD; wgid = (xcd < r ? xcd * (q + 1) : r * (q + 1) + (xcd - r) * q) + off; }
        const int nig = WGM * nN, gid = wgid / nig, fm = gid * WGM, gsz = (nM - fm) < WGM ? (nM - fm) : WGM;
        u.pm = fm + ((wgid % nig) % gsz); u.pn = (wgid % nig) / gsz; return true;
    }
    __device__ __forceinline__ void a_ready(const Unit&) const {}
    __device__ __forceinline__ void done(const Unit&) const {}
};


__device__ __forceinline__ unsigned cvt_pk_bf16(float lo, float hi) { unsigned r; asm volatile("v_cvt_pk_bf16_f32 %0, %1, %2" : "=v"(r) : "v"(lo), "v"(hi)); return r; }

template <class Epi, class Sched, bool ALIGN_EPI = false, bool SP2 = false>
__device__ __forceinline__ void gemm_phase(PG8_LAS unsigned char* lds, const Gemm g, const Sched& S, const Epi& E) {
    const int tid = threadIdx.x, wid = __builtin_amdgcn_readfirstlane(tid >> 6), lane = tid & 63, wr = wid >> 2, wc = wid & 3, fr = lane & 15, fq = lane >> 4;
    const int K = g.K, nt = K / BK;
    unsigned voffA[2], voffB[2];
#pragma unroll
    for (int i = 0; i < 2; ++i) { int R, C; stage_rc(tid * 16 + i * 8192, R, C); const int Rb = Epi::PERM ? ((R & ~31) + perm32(R & 31)) : R;
        voffA[i] = (unsigned)(R * K + C) * 2u; voffB[i] = (unsigned)(Rb * K + C) * 2u; }
    const size_t kstep = (size_t)(BK * 2);
    const size_t hstep = (size_t)HALF * K * 2;
    const size_t tstep = 2 * hstep;
    const unsigned ldsw = (unsigned)wid * 1024u;
    const int aoff = lds_byte(wr * 64 + fr, fq * 8), boff = lds_byte(wc * 32 + fr, fq * 8);
#define PG8_SA(b, h) (((b) * 2 + (h)) * HTB)
#define PG8_SB(b, h) ((4 + (b) * 2 + (h)) * HTB)
#define PG8_STAGE(bufoff, gbase, voff) do { _Pragma("unroll") for (int _i = 0; _i < 2; ++_i) \
        __builtin_amdgcn_global_load_lds((const unsigned*)((const char*)(gbase) + (voff)[_i]), (PG8_LAS unsigned*)(lds + (bufoff) + ldsw + _i * 8192), 16, 0, 0); } while (0)
#define PG8_LDA(dst, b, h) do { _Pragma("unroll") for (int m = 0; m < 4; ++m) _Pragma("unroll") for (int k = 0; k < 2; ++k) dst[m][k] = *(const PG8_LAS bf16x8*)(lds + PG8_SA(b, h) + aoff + m * 2048 + k * 1024); } while (0)
#define PG8_LDB(dst, b, h) do { _Pragma("unroll") for (int n = 0; n < 2; ++n) _Pragma("unroll") for (int k = 0; k < 2; ++k) dst[n][k] = *(const PG8_LAS bf16x8*)(lds + PG8_SB(b, h) + boff + n * 2048 + k * 1024); } while (0)
#define PG8_MMA(ai, bj, At, Bt) do { __builtin_amdgcn_s_setprio(1); _Pragma("unroll") for (int m = 0; m < 4; ++m) _Pragma("unroll") for (int n = 0; n < 2; ++n) _Pragma("unroll") for (int k = 0; k < 2; ++k) \
        acc[ai][bj][m][n] = __builtin_amdgcn_mfma_f32_16x16x32_bf16(Bt[n][k], At[m][k], acc[ai][bj][m][n], 0, 0, 0); __builtin_amdgcn_s_setprio(0); } while (0)
#define PG8_WAIT_V(n) asm volatile("s_waitcnt vmcnt(" #n ")" ::: "memory")
#define PG8_WAIT_L(n) asm volatile("s_waitcnt lgkmcnt(" #n ")" ::: "memory")
#define PG8_BAR __builtin_amdgcn_s_barrier()
#define PG8_SCHED __builtin_amdgcn_sched_barrier(0)
    Unit cur, nxt; int ui = 0;
    if (!S.next(0, cur)) return;
    f32x4 acc[2][2][4][2];
#pragma unroll
    for (int a = 0; a < 2; ++a)
#pragma unroll
        for (int b = 0; b < 2; ++b)
#pragma unroll
            for (int m = 0; m < 4; ++m)
#pragma unroll
                for (int n = 0; n < 2; ++n) acc[a][b][m][n] = (f32x4){0.f, 0.f, 0.f, 0.f};
    bf16x8 At[4][2], B0[2][2], B1[2][2];
    const char* cA = (const char*)g.A + (size_t)cur.pm * tstep; const char* cB = (const char*)g.Bt + (size_t)cur.pn * tstep;
    S.a_ready(cur);
    if constexpr (SP2) {
        PG8_STAGE(PG8_SB(0, 0), cB, voffB); PG8_STAGE(PG8_SB(0, 1), cB + hstep, voffB); PG8_STAGE(PG8_SA(0, 0), cA, voffA); PG8_STAGE(PG8_SA(0, 1), cA + hstep, voffA);
        if (wr == 1) PG8_BAR;
        PG8_WAIT_V(2); PG8_BAR;
        PG8_STAGE(PG8_SB(1, 0), cB + kstep, voffB); PG8_STAGE(PG8_SA(1, 0), cA + kstep, voffA); PG8_STAGE(PG8_SB(1, 1), cB + hstep + kstep, voffB);
        PG8_WAIT_V(6); PG8_BAR;
    } else {
        PG8_STAGE(PG8_SB(0, 0), cB, voffB); PG8_STAGE(PG8_SA(0, 0), cA, voffA); PG8_STAGE(PG8_SB(0, 1), cB + hstep, voffB); PG8_STAGE(PG8_SA(0, 1), cA + hstep, voffA);
        if (wr == 1) PG8_BAR;
        PG8_WAIT_V(4); PG8_BAR;
        PG8_STAGE(PG8_SB(1, 0), cB + kstep, voffB); PG8_STAGE(PG8_SA(1, 0), cA + kstep, voffA); PG8_STAGE(PG8_SB(1, 1), cB + hstep + kstep, voffB);
        PG8_WAIT_V(6); PG8_BAR;
    }
    for (;;) {
        const bool has_next = S.next(ui + 1, nxt);
        const char* nA = has_next ? (const char*)g.A + (size_t)nxt.pm * tstep : cA; const char* nB = has_next ? (const char*)g.Bt + (size_t)nxt.pn * tstep : cB;
        for (int t = 0; t < nt; t += 2) {
            const bool last = (t == nt - 2);
            const char* a1 = cA + (size_t)(t + 1) * kstep;
            const char* a2 = last ? nA : cA + (size_t)(t + 2) * kstep; const char* b2 = last ? nB : cB + (size_t)(t + 2) * kstep;
            const char* a3 = a2 + kstep; const char* b3 = b2 + kstep;
            if (last && has_next) S.a_ready(nxt);
            if constexpr (SP2) {
            PG8_LDB(B0, 0, 0); PG8_LDB(B1, 0, 1); PG8_SCHED; PG8_LDA(At, 0, 0); PG8_STAGE(PG8_SA(1, 1), a1 + hstep, voffA);
            PG8_WAIT_V(8); PG8_WAIT_L(0); PG8_BAR; PG8_MMA(0, 0, At, B0); PG8_MMA(0, 1, At, B1); PG8_BAR; PG8_SCHED;
            PG8_LDA(At, 0, 1); PG8_STAGE(PG8_SB(0, 0), b2, voffB); PG8_STAGE(PG8_SB(0, 1), b2 + hstep, voffB); PG8_STAGE(PG8_SA(0, 0), a2, voffA);
            PG8_WAIT_V(8); PG8_WAIT_L(0); PG8_BAR; PG8_MMA(1, 0, At, B0); PG8_MMA(1, 1, At, B1); PG8_BAR; PG8_SCHED;
            PG8_LDB(B0, 1, 0); PG8_LDB(B1, 1, 1); PG8_SCHED; PG8_LDA(At, 1, 0); PG8_STAGE(PG8_SA(0, 1), a2 + hstep, voffA);
            PG8_WAIT_V(8); PG8_WAIT_L(0); PG8_BAR; PG8_MMA(0, 0, At, B0); PG8_MMA(0, 1, At, B1); PG8_BAR; PG8_SCHED;
            PG8_LDA(At, 1, 1); PG8_STAGE(PG8_SB(1, 0), b3, voffB); PG8_STAGE(PG8_SB(1, 1), b3 + hstep, voffB); PG8_STAGE(PG8_SA(1, 0), a3, voffA);
            PG8_WAIT_V(8); PG8_WAIT_L(0); PG8_BAR; PG8_MMA(1, 0, At, B0); PG8_MMA(1, 1, At, B1); PG8_BAR; PG8_SCHED;
            } else {
            PG8_LDB(B0, 0, 0); PG8_SCHED; PG8_LDA(At, 0, 0); PG8_STAGE(PG8_SA(1, 1), a1 + hstep, voffA);
            PG8_WAIT_L(8); PG8_BAR; PG8_WAIT_L(0); PG8_MMA(0, 0, At, B0); PG8_BAR; PG8_SCHED;
            PG8_LDB(B1, 0, 1); PG8_STAGE(PG8_SB(0, 0), b2, voffB);
            PG8_BAR; PG8_WAIT_L(0); PG8_MMA(0, 1, At, B1); PG8_BAR;
            PG8_LDA(At, 0, 1); PG8_STAGE(PG8_SA(0, 0), a2, voffA);
            PG8_BAR; PG8_WAIT_L(0); PG8_MMA(1, 0, At, B0); PG8_BAR; PG8_SCHED;
            PG8_STAGE(PG8_SB(0, 1), b2 + hstep, voffB);
            PG8_WAIT_V(6); PG8_BAR; PG8_MMA(1, 1, At, B1); PG8_BAR;
            PG8_LDB(B0, 1, 0); PG8_SCHED; PG8_LDA(At, 1, 0); PG8_STAGE(PG8_SA(0, 1), a2 + hstep, voffA);
            PG8_WAIT_L(8); PG8_BAR; PG8_WAIT_L(0); PG8_MMA(0, 0, At, B0); PG8_BAR; PG8_SCHED;
            PG8_LDB(B1, 1, 1); PG8_STAGE(PG8_SB(1, 0), b3, voffB);
            PG8_BAR; PG8_WAIT_L(0); PG8_MMA(0, 1, At, B1); PG8_BAR;
            PG8_LDA(At, 1, 1); PG8_STAGE(PG8_SA(1, 0), a3, voffA);
            PG8_BAR; PG8_WAIT_L(0); PG8_MMA(1, 0, At, B0); PG8_BAR; PG8_SCHED;
            PG8_STAGE(PG8_SB(1, 1), b3 + hstep, voffB);
            PG8_WAIT_V(6); PG8_BAR; PG8_MMA(1, 1, At, B1); PG8_BAR;
            }
        }
        if constexpr (ALIGN_EPI) { if (wr == 0) PG8_BAR; }
        if constexpr (!Epi::AFTER_DRAIN) { E(acc, cur, wr, wc, fr, fq); S.done(cur); }
        if (!has_next) break;
#pragma unroll
        for (int a = 0; a < 2; ++a)
#pragma unroll
            for (int b = 0; b < 2; ++b)
#pragma unroll
                for (int m = 0; m < 4; ++m)
#pragma unroll
                    for (int n = 0; n < 2; ++n) acc[a][b][m][n] = (f32x4){0.f, 0.f, 0.f, 0.f};
        cur = nxt; cA = nA; cB = nB; ++ui;
        if constexpr (ALIGN_EPI) { if (wr == 1) PG8_BAR; }
    }
    PG8_WAIT_V(0);
    if constexpr (!ALIGN_EPI) { if (wr == 0) PG8_BAR; }
    PG8_BAR;
    if constexpr (Epi::AFTER_DRAIN) { E.fused(acc, cur, wr, wc, fr, fq, lds, wid, lane); S.done(cur); }
#undef PG8_SA
#undef PG8_SB
#undef PG8_STAGE
#undef PG8_LDA
#undef PG8_LDB
#undef PG8_MMA
#undef PG8_WAIT_V
#undef PG8_WAIT_L
#undef PG8_BAR
#undef PG8_SCHED
}

__device__ __forceinline__ float bf2f(unsigned short b) { return __uint_as_float(((unsigned)b) << 16); }
__device__ __forceinline__ unsigned short f2bf(float f) { unsigned u = __float_as_uint(f); u += 0x7FFFu + ((u >> 16) & 1u); return (unsigned short)(u >> 16); }
__device__ __forceinline__ float sigmoid_f(float x) { return __builtin_amdgcn_rcpf(1.f + __expf(-x)); }
__device__ __forceinline__ float silu_f(float x) { return x * sigmoid_f(x); }
__device__ __forceinline__ float gelu_f(float x) { const float u = 0.7978845608028654f * (x + 0.044715f * x * x * x); return x * sigmoid_f(2.f * u); }

template <int MODE> struct EpiM {
    static constexpr bool PERM = true, AFTER_DRAIN = false;
    bf16_t* O; int ldc; const float* bias; const bf16_t* G; const bf16_t* UZ; float qscale;
    __device__ __forceinline__ void operator()(const f32x4 (&acc)[2][2][4][2], const Unit& u, int wr, int wc, int fr, int fq) const {
        const int row0 = u.pm * BM + wr * 64 + fr; const int colt = u.pn * BM; const int col0 = colt + wc * 32 + 8 * fq;
        int act = 0;
        if (MODE == 0) { const int seg = colt >> 10; act = (seg <= 1) ? 1 : ((seg == 2 || seg == 6) ? 2 : (seg == 3 ? 3 : 0)); }
        if (MODE == 2) { act = (colt >= 1024) ? 2 : 0; }
#pragma unroll
        for (int ai = 0; ai < 2; ++ai)
#pragma unroll
            for (int m = 0; m < 4; ++m) {
                const int row = row0 + ai * HALF + m * 16;
#pragma unroll
                for (int bj = 0; bj < 2; ++bj) {
                    const int col = col0 + bj * HALF;
                    float v[8];
#pragma unroll
                    for (int j = 0; j < 4; ++j) { v[j] = acc[ai][bj][m][0][j]; v[4 + j] = acc[ai][bj][m][1][j]; }
                    if (MODE == 0 || MODE == 2) {
                        if (act == 1) {
#pragma unroll
                            for (int j = 0; j < 8; ++j) v[j] = gelu_f(v[j]);
                        } else if (act == 2) {
#pragma unroll
                            for (int j = 0; j < 8; ++j) v[j] = silu_f(v[j]);
                        } else if (act == 3) {
#pragma unroll
                            for (int j = 0; j < 8; ++j) v[j] = v[j] * qscale;
                        }
                    }
                    if (MODE == 3) {
                        const f32x4 b0 = *(const f32x4*)(bias + col), b1 = *(const f32x4*)(bias + col + 4);
                        const bf16x8 gv = *(const bf16x8*)(G + (size_t)row * 1024 + col);
                        const bf16x8 zv = *(const bf16x8*)(UZ + (size_t)row * 2048 + 1024 + col);
#pragma unroll
                        for (int j = 0; j < 8; ++j) { const float t = v[j] + (j < 4 ? b0[j & 3] : b1[j & 3]); v[j] = bf2f((unsigned short)gv[j]) * sigmoid_f(t) * bf2f((unsigned short)zv[j]); }
                    }
                    u32x4 w; w.x = cvt_pk_bf16(v[0], v[1]); w.y = cvt_pk_bf16(v[2], v[3]); w.z = cvt_pk_bf16(v[4], v[5]); w.w = cvt_pk_bf16(v[6], v[7]);
                    *(u32x4*)(O + (size_t)row * ldc + col) = w;
                }
            }
    }
};
}

using pg8::bf16_t; using pg8::bf16x8; using pg8::f32x4; using pg8::u32x4; using pg8::bf2f; using pg8::f2bf; using pg8::silu_f; using pg8::gelu_f; using pg8::sigmoid_f; using pg8::cvt_pk_bf16;
#define LAS __attribute__((address_space(3)))
typedef unsigned u32x2 __attribute__((ext_vector_type(2)));
typedef float f32x2v __attribute__((ext_vector_type(2)));

constexpr int NTOK = 16384, DM = 2048, SEQ = 4096;
constexpr float EPS = 1e-6f;
constexpr int LDS_BYTES = 147456;
constexpr size_t OFF_MODP = 4096;
constexpr size_t OFF_W1T = OFF_MODP + (size_t)8 * 2 * 4 * 6144 * 4;
constexpr size_t OFF_W2T = OFF_W1T + (size_t)7168 * 2048 * 2;
constexpr size_t OFF_W3T = OFF_W2T + (size_t)2048 * 2048 * 2;
constexpr size_t OFF_W4T = OFF_W3T + (size_t)2048 * 2048 * 2;
constexpr size_t OFF_W5T = OFF_W4T + (size_t)1024 * 1024 * 2;
constexpr size_t OFF_HB = OFF_W5T + (size_t)2048 * 1024 * 2;
constexpr size_t OFF_MIX = OFF_HB + (size_t)NTOK * 2048 * 2;
constexpr size_t OFF_PROJ = OFF_MIX + (size_t)NTOK * 2048 * 2;
constexpr size_t OFF_Y0 = OFF_PROJ;
constexpr size_t OFF_UZ = OFF_Y0 + (size_t)NTOK * 2048 * 2;
constexpr size_t OFF_Y1 = OFF_UZ + (size_t)NTOK * 2048 * 2;
constexpr size_t WS_END = OFF_PROJ + (size_t)NTOK * 7168 * 2;

struct Params {
    const float *x, *c, *ln_pre_g, *ln_post_g, *w_mod, *b_mod, *w_in_ab, *w_out_ab, *sgu_norm_g, *sgu_w, *sgu_b,
        *w_in_ssm, *w_out_ssm, *lam_re, *lam_im, *b_re, *b_im, *c_re, *c_im, *d_skip, *log_dt, *w_glu, *b_glu;
    float* out; unsigned char* ws;
};

__device__ __forceinline__ float wave_sum(float v) {
#pragma unroll
    for (int o = 1; o < 64; o <<= 1) v += __shfl_xor(v, o);
    return v;
}
__device__ __forceinline__ void wave_lds_sync() { asm volatile("s_waitcnt lgkmcnt(0)" ::: "memory"); }
__device__ __forceinline__ f32x4 mfma16(bf16x8 a, bf16x8 b, f32x4 c) { return __builtin_amdgcn_mfma_f32_16x16x32_bf16(a, b, c, 0, 0, 0); }

__device__ __forceinline__ void phase_prep(const Params& p, LAS unsigned char* lds) {
    LAS float* ldsf = (LAS float*)lds;
    const int tid = threadIdx.x;
    constexpr int N_MOD = 192, I1 = 32 * 112, I2 = 32 * 32, I3 = 32 * 32, I4 = 16 * 16, I5 = 16 * 32, NITEMS = N_MOD + I1 + I2 + I3 + I4 + I5;
    for (int it = blockIdx.x; it < NITEMS; it += gridDim.x) {
        __syncthreads();
        if (it < N_MOD) {
            const int ks = it & 7, chunk = it >> 3, l = chunk / 12, col0 = (chunk % 12) * 512;
            for (int i = tid; i < 1024; i += 512) { const int b = i >> 8, k = i & 255; ldsf[i] = silu_f(p.c[b * 2048 + ks * 256 + k]); }
            __syncthreads();
            const float* W = p.w_mod + (size_t)l * 2048 * 6144 + (size_t)(ks * 256) * 6144 + col0 + tid;
            float a0 = 0.f, a1 = 0.f, a2 = 0.f, a3 = 0.f;
#pragma unroll 8
            for (int k = 0; k < 256; ++k) { const float w = W[(size_t)k * 6144]; a0 += ldsf[k] * w; a1 += ldsf[256 + k] * w; a2 += ldsf[512 + k] * w; a3 += ldsf[768 + k] * w; }
            float* o = (float*)(p.ws + OFF_MODP) + ((size_t)(ks * 2 + l) * 4) * 6144 + col0 + tid;
            o[0] = a0; o[6144] = a1; o[2 * 6144] = a2; o[3 * 6144] = a3;
        } else {
            int r = it - N_MOD; const float* W; bf16_t* WT; int K, N;
            if (r < I1) { W = p.w_in_ab; WT = (bf16_t*)(p.ws + OFF_W1T); K = 2048; N = 7168; }
            else if ((r -= I1) < I2) { W = p.w_out_ab; WT = (bf16_t*)(p.ws + OFF_W2T); K = 2048; N = 2048; }
            else if ((r -= I2) < I3) { W = p.w_in_ssm; WT = (bf16_t*)(p.ws + OFF_W3T); K = 2048; N = 2048; }
            else if ((r -= I3) < I4) { W = p.w_glu; WT = (bf16_t*)(p.ws + OFF_W4T); K = 1024; N = 1024; }
            else { r -= I4; W = p.w_out_ssm; WT = (bf16_t*)(p.ws + OFF_W5T); K = 1024; N = 2048; }
            const int nblk = N / 64, kb = r / nblk, nb = r % nblk, k0 = kb * 64, n0 = nb * 64;
#pragma unroll
            for (int i = 0; i < 8; ++i) { const int idx = tid + 512 * i, rr = idx >> 6, cc = idx & 63; ldsf[rr * 65 + cc] = W[(size_t)(k0 + rr) * N + n0 + cc]; }
            __syncthreads();
#pragma unroll
            for (int i = 0; i < 4; ++i) { const int idx = tid + 512 * i, nn = idx >> 5, c2 = idx & 31;
                const float v0 = ldsf[(2 * c2) * 65 + nn], v1 = ldsf[(2 * c2 + 1) * 65 + nn];
                *(unsigned*)(WT + (size_t)(n0 + nn) * K + k0 + 2 * c2) = cvt_pk_bf16(v0, v1); }
        }
    }
}

__device__ __forceinline__ float mod_val(const Params& p, int l, int b, int j) {
    float s = p.b_mod[l * 6144 + j];
    const float* mp = (const float*)(p.ws + OFF_MODP) + ((size_t)l * 4 + b) * 6144 + j;
#pragma unroll
    for (int ks = 0; ks < 8; ++ks) s += mp[(size_t)ks * 2 * 4 * 6144];
    return s;
}
template <int WHICH> __device__ __forceinline__ void phase_rows(const Params& p, LAS unsigned char* lds) {
    LAS float* vA = (LAS float*)lds;
    LAS float* vB = vA + 2048;
    LAS float* vG = vB + 2048;
    const int tid = threadIdx.x, wid = tid >> 6, lane = tid & 63;
    bf16_t* HB = (bf16_t*)(p.ws + OFF_HB);
    for (int chunk = blockIdx.x; chunk < NTOK / 64; chunk += gridDim.x) {
        const int row0 = chunk * 64, b = row0 >> 12;
        __syncthreads();
        for (int j = tid; j < 2048; j += 512) {
            if (WHICH == 0) { vA[j] = p.ln_pre_g[j] * (1.f + mod_val(p, 0, b, 2048 + j)); vB[j] = mod_val(p, 0, b, j); }
            if (WHICH == 1) { vG[j] = mod_val(p, 0, b, 4096 + j) * p.ln_post_g[j]; vA[j] = p.ln_pre_g[2048 + j] * (1.f + mod_val(p, 1, b, 2048 + j)); vB[j] = mod_val(p, 1, b, j); }
            if (WHICH == 2) { vG[j] = mod_val(p, 1, b, 4096 + j) * p.ln_post_g[2048 + j]; }
        }
        __syncthreads();
        for (int r = wid; r < 64; r += 8) {
            const size_t row = (size_t)(row0 + r);
            f32x4 xv[8];
            const float* xin = (WHICH == 2) ? p.out : p.x;
#pragma unroll
            for (int j = 0; j < 8; ++j) xv[j] = *(const f32x4*)(xin + row * 2048 + (lane + 64 * j) * 4);
            if (WHICH != 0) {
                const bf16_t* Y = (const bf16_t*)(p.ws + (WHICH == 1 ? OFF_Y0 : OFF_Y1));
                f32x4 yv[8]; float ssy = 0.f;
#pragma unroll
                for (int j = 0; j < 8; ++j) { const u32x2 w = *(const u32x2*)(Y + row * 2048 + (lane + 64 * j) * 4);
                    yv[j][0] = __uint_as_float(w.x << 16); yv[j][1] = __uint_as_float(w.x & 0xffff0000u); yv[j][2] = __uint_as_float(w.y << 16); yv[j][3] = __uint_as_float(w.y & 0xffff0000u);
                    ssy += yv[j][0] * yv[j][0] + yv[j][1] * yv[j][1] + yv[j][2] * yv[j][2] + yv[j][3] * yv[j][3]; }
                const float ry = rsqrtf(wave_sum(ssy) * (1.f / 2048.f) + EPS);
#pragma unroll
                for (int j = 0; j < 8; ++j) { const f32x4 gv = *(const LAS f32x4*)(vG + (lane + 64 * j) * 4);
#pragma unroll
                    for (int e = 0; e < 4; ++e) xv[j][e] += gv[e] * (yv[j][e] * ry);
                    *(f32x4*)(p.out + row * 2048 + (lane + 64 * j) * 4) = xv[j]; }
            }
            if (WHICH != 2) {
                float ss = 0.f;
#pragma unroll
                for (int j = 0; j < 8; ++j) ss += xv[j][0] * xv[j][0] + xv[j][1] * xv[j][1] + xv[j][2] * xv[j][2] + xv[j][3] * xv[j][3];
                const float rx = rsqrtf(wave_sum(ss) * (1.f / 2048.f) + EPS);
#pragma unroll
                for (int j = 0; j < 8; ++j) { const f32x4 av = *(const LAS f32x4*)(vA + (lane + 64 * j) * 4), bv = *(const LAS f32x4*)(vB + (lane + 64 * j) * 4);
                    u32x2 w; w.x = cvt_pk_bf16(xv[j][0] * rx * av[0] + bv[0], xv[j][1] * rx * av[1] + bv[1]); w.y = cvt_pk_bf16(xv[j][2] * rx * av[2] + bv[2], xv[j][3] * rx * av[3] + bv[3]);
                    *(u32x2*)(HB + row * 2048 + (lane + 64 * j) * 4) = w; }
            }
        }
    }
}

__device__ __forceinline__ void sgu_item(const Params& p, LAS unsigned char* lds, int b, int n, int h) {
    LAS bf16_t* Ws = (LAS bf16_t*)lds;
    LAS bf16_t* VT = Ws + 128 * 136;
    const int tid = threadIdx.x, wid = tid >> 6, lane = tid & 63, fr = lane & 15, g = lane >> 4;
    const bf16_t* P = (const bf16_t*)(p.ws + OFF_PROJ);
    bf16_t* MIX = (bf16_t*)(p.ws + OFF_MIX);
    const size_t tok0 = (size_t)b * SEQ + (size_t)n * 128;
    __syncthreads();
    const float* Wg = p.sgu_w + (size_t)h * 16384;
#pragma unroll
    for (int i = 0; i < 8; ++i) { const int idx = tid + 512 * i, r = idx >> 5, c4 = (idx & 31) * 4;
        f32x4 w = *(const f32x4*)(Wg + r * 128 + c4);
        w[0] = (c4 + 0 <= r) ? w[0] : 0.f; w[1] = (c4 + 1 <= r) ? w[1] : 0.f; w[2] = (c4 + 2 <= r) ? w[2] : 0.f; w[3] = (c4 + 3 <= r) ? w[3] : 0.f;
        u32x2 o; o.x = cvt_pk_bf16(w[0], w[1]); o.y = cvt_pk_bf16(w[2], w[3]);
        *(LAS u32x2*)(Ws + r * 136 + c4) = o; }
    {
        const int s = tid >> 2, q4 = tid & 3;
        const bf16_t* src = P + (tok0 + s) * 7168 + 1024 + h * 128 + q4 * 32;
        bf16x8 v[4]; float ss = 0.f;
#pragma unroll
        for (int i = 0; i < 4; ++i) { v[i] = *(const bf16x8*)(src + 8 * i);
#pragma unroll
            for (int j = 0; j < 8; ++j) { const float f = bf2f((unsigned short)v[i][j]); ss += f * f; } }
        ss += __shfl_xor(ss, 1); ss += __shfl_xor(ss, 2);
        const float rn = rsqrtf(ss * (1.f / 128.f) + EPS);
#pragma unroll
        for (int i = 0; i < 4; ++i)
#pragma unroll
            for (int j = 0; j < 8; ++j) { const int d = q4 * 32 + 8 * i + j; VT[d * 136 + s] = f2bf(bf2f((unsigned short)v[i][j]) * rn * p.sgu_norm_g[h * 128 + d]); }
    }
    __syncthreads();
    const int nks = (wid >> 1) + 1;
    f32x4 acc[8];
#pragma unroll
    for (int db = 0; db < 8; ++db) acc[db] = (f32x4){0.f, 0.f, 0.f, 0.f};
#pragma unroll
    for (int ks = 0; ks < 4; ++ks) {
        if (ks < nks) {
            const bf16x8 bfrag = *(const LAS bf16x8*)(Ws + (16 * wid + fr) * 136 + 8 * g + 32 * ks);
#pragma unroll
            for (int db = 0; db < 8; ++db) { const bf16x8 afrag = *(const LAS bf16x8*)(VT + (16 * db + fr) * 136 + 8 * g + 32 * ks); acc[db] = mfma16(afrag, bfrag, acc[db]); }
        }
    }
    const int t = 16 * wid + fr; const size_t tok = tok0 + t; const float bs = p.sgu_b[h * 128 + t];
#pragma unroll
    for (int db = 0; db < 8; ++db) { const int col = h * 128 + 16 * db + 4 * g;
        const u32x2 gu = *(const u32x2*)(P + tok * 7168 + col), sz = *(const u32x2*)(P + tok * 7168 + 2048 + col);
        const float o0 = __uint_as_float(gu.x << 16) * (acc[db][0] + bs) * __uint_as_float(sz.x << 16);
        const float o1 = __uint_as_float(gu.x & 0xffff0000u) * (acc[db][1] + bs) * __uint_as_float(sz.x & 0xffff0000u);
        const float o2 = __uint_as_float(gu.y << 16) * (acc[db][2] + bs) * __uint_as_float(sz.y << 16);
        const float o3 = __uint_as_float(gu.y & 0xffff0000u) * (acc[db][3] + bs) * __uint_as_float(sz.y & 0xffff0000u);
        u32x2 w; w.x = cvt_pk_bf16(o0, o1); w.y = cvt_pk_bf16(o2, o3);
        *(u32x2*)(MIX + tok * 2048 + col) = w; }
}

__device__ __forceinline__ void attn_item(const Params& p, LAS unsigned char* lds, int b, int h, int qb) {
    LAS bf16_t* Ks = (LAS bf16_t*)lds;
    LAS bf16_t* VTs = Ks + 64 * 136;
    const int tid = threadIdx.x, wid = tid >> 6, lane = tid & 63, fr = lane & 15, g = lane >> 4;
    const bf16_t* P = (const bf16_t*)(p.ws + OFF_PROJ);
    bf16_t* MIX = (bf16_t*)(p.ws + OFF_MIX);
    const size_t tokb = (size_t)b * SEQ;
    const int qrow = qb * 128 + wid * 16 + fr;
    const int qmax_w = qb * 128 + wid * 16 + 15;
    bf16x8 qf[4];
    { const bf16_t* qp = P + (tokb + qrow) * 7168 + 3072 + h * 128 + 8 * g;
#pragma unroll
      for (int ks = 0; ks < 4; ++ks) qf[ks] = *(const bf16x8*)(qp + 32 * ks); }
    f32x4 oacc[8];
#pragma unroll
    for (int db = 0; db < 8; ++db) oacc[db] = (f32x4){0.f, 0.f, 0.f, 0.f};
    float carry = 0.f;
    for (int kt = 2 * qb + 1; kt >= 0; --kt) {
        __syncthreads();
#pragma unroll
        for (int i = 0; i < 2; ++i) { const int idx = tid + 512 * i, key = idx >> 4, d8 = (idx & 15) * 8;
            const bf16_t* src = P + (tokb + (size_t)kt * 64 + key) * 7168 + 4096 + h * 128 + d8;
            const bf16x8 kv = *(const bf16x8*)src, vv = *(const bf16x8*)(src + 1024);
            *(LAS bf16x8*)(Ks + key * 136 + d8) = kv;
#pragma unroll
            for (int j = 0; j < 8; ++j) VTs[(d8 + j) * 72 + key] = (bf16_t)vv[j]; }
        __syncthreads();
        if (kt * 64 < qmax_w) {
            f32x4 s[4];
#pragma unroll
            for (int kb = 0; kb < 4; ++kb) { s[kb] = (f32x4){0.f, 0.f, 0.f, 0.f};
#pragma unroll
                for (int ks = 0; ks < 4; ++ks) { const bf16x8 a = *(const LAS bf16x8*)(Ks + (16 * kb + fr) * 136 + 8 * g + 32 * ks); s[kb] = mfma16(a, qf[ks], s[kb]); } }
            float w[4][4];
#pragma unroll
            for (int kk = 0; kk < 4; ++kk) { const int kb = 3 - kk;
                float lb[4], lk[4];
#pragma unroll
                for (int r = 0; r < 4; ++r) { const float z = s[kb][r]; const int kpos = kt * 64 + 16 * kb + 4 * g + r;
                    const float e = __expf(-fabsf(z)); const float lbv = fminf(z, 0.f) - __logf(1.f + e);
                    lb[r] = lbv; lk[r] = (kpos < qrow) ? (lbv - z) : 0.f; }
                const float e2 = lk[3], e1 = e2 + lk[2], e0 = e1 + lk[1], tot = e0 + lk[0];
                const float T0 = __shfl(tot, fr), T1 = __shfl(tot, fr + 16), T2 = __shfl(tot, fr + 32), T3 = __shfl(tot, fr + 48);
                const float base = carry + ((g < 1) ? T1 : 0.f) + ((g < 2) ? T2 : 0.f) + ((g < 3) ? T3 : 0.f);
                const float ex[4] = {e0, e1, e2, 0.f};
#pragma unroll
                for (int r = 0; r < 4; ++r) { const int kpos = kt * 64 + 16 * kb + 4 * g + r; w[kb][r] = (kpos < qrow) ? __expf(lb[r] + base + ex[r]) : 0.f; }
                carry += (T0 + T1) + (T2 + T3);
            }
#pragma unroll
            for (int pp = 0; pp < 2; ++pp) {
                u32x4 pw; pw.x = cvt_pk_bf16(w[2 * pp][0], w[2 * pp][1]); pw.y = cvt_pk_bf16(w[2 * pp][2], w[2 * pp][3]);
                pw.z = cvt_pk_bf16(w[2 * pp + 1][0], w[2 * pp + 1][1]); pw.w = cvt_pk_bf16(w[2 * pp + 1][2], w[2 * pp + 1][3]);
                const bf16x8 pf = __builtin_bit_cast(bf16x8, pw);
#pragma unroll
                for (int db = 0; db < 8; ++db) {
                    const u32x2 lo = *(const LAS u32x2*)(VTs + (16 * db + fr) * 72 + 32 * pp + 4 * g), hi = *(const LAS u32x2*)(VTs + (16 * db + fr) * 72 + 32 * pp + 16 + 4 * g);
                    u32x4 av; av.x = lo.x; av.y = lo.y; av.z = hi.x; av.w = hi.y;
                    oacc[db] = mfma16(__builtin_bit_cast(bf16x8, av), pf, oacc[db]);
                }
            }
        }
    }
    const size_t tok = tokb + qrow;
#pragma unroll
    for (int db = 0; db < 8; ++db) { const int col = h * 128 + 16 * db + 4 * g;
        const u32x2 sz = *(const u32x2*)(P + tok * 7168 + 6144 + col);
        u32x2 w; w.x = cvt_pk_bf16(oacc[db][0] * __uint_as_float(sz.x << 16), oacc[db][1] * __uint_as_float(sz.x & 0xffff0000u));
        w.y = cvt_pk_bf16(oacc[db][2] * __uint_as_float(sz.y << 16), oacc[db][3] * __uint_as_float(sz.y & 0xffff0000u));
        *(u32x2*)(MIX + tok * 2048 + 1024 + col) = w; }
}

__device__ __forceinline__ void phase_mixers(const Params& p, LAS unsigned char* lds) {
    const int G = gridDim.x;
    for (int i = blockIdx.x, rnd = 0; i < 1024; i += G, ++rnd) {
        const int j = i & 255, bh = j & 31, q8 = j >> 5;
        const int grp = i >> 8;
        int qb;
        if (grp == 0) qb = 31 - q8; else if (grp == 1) qb = 16 + q8; else if (grp == 2) qb = 15 - q8; else qb = q8;
        attn_item(p, lds, bh >> 3, bh & 7, qb);
    }
    for (int i = blockIdx.x; i < 1024; i += G) sgu_item(p, lds, i >> 8, (i >> 3) & 31, i & 7);
}

__device__ __forceinline__ void ssm_coef(const Params& p, int grp, int pp, float& are, float& aim, float& cre, float& cim) {
    const float dt = expf(p.log_dt[grp]); const float lr = p.lam_re[grp * 64 + pp], li = p.lam_im[grp * 64 + pp];
    const float mag = expf(lr * dt); are = mag * cosf(li * dt); aim = mag * sinf(li * dt);
    const float den = lr * lr + li * li, nr = are - 1.f;
    cre = (nr * lr + aim * li) / den; cim = (aim * lr - nr * li) / den;
}
__device__ __forceinline__ void ssm_item(const Params& p, LAS unsigned char* lds, int b, int grp) {
    LAS float* aTab = (LAS float*)lds;
    LAS bf16_t* BmT = (LAS bf16_t*)(lds + 1024);
    LAS bf16_t* CmT = (LAS bf16_t*)(lds + 1024 + 4096);
    LAS float* S = (LAS float*)(lds + 9472);
    const int tid = threadIdx.x, wid = tid >> 6, lane = tid & 63, fr = lane & 15, g = lane >> 4;
    LAS float* BU = (LAS float*)(lds + 42240 + wid * 12800);
    LAS bf16_t* Hs = (LAS bf16_t*)(lds + 42240 + wid * 12800 + 8448);
    __syncthreads();
    if (tid < 64) { float are, aim, cre, cim; ssm_coef(p, grp, tid, are, aim, cre, cim); aTab[tid] = are; aTab[64 + tid] = aim;
        float pr = are, pi = aim;
#pragma unroll
        for (int i = 0; i < 6; ++i) { const float nr2 = pr * pr - pi * pi, ni2 = 2.f * pr * pi; pr = nr2; pi = ni2; }
        aTab[128 + tid] = pr; aTab[192 + tid] = pi; }
#pragma unroll
    for (int i = 0; i < 2; ++i) { const int idx = tid + 512 * i, pp = idx >> 4, c = idx & 15; float are, aim, cre, cim; ssm_coef(p, grp, pp, are, aim, cre, cim);
        const float br = p.b_re[((size_t)grp * 64 + pp) * 16 + c], bi = p.b_im[((size_t)grp * 64 + pp) * 16 + c];
        BmT[(2 * pp) * 16 + c] = f2bf(cre * br - cim * bi); BmT[(2 * pp + 1) * 16 + c] = f2bf(cre * bi + cim * br); }
#pragma unroll
    for (int i = 0; i < 2; ++i) { const int idx = tid + 512 * i, c = idx >> 6, pp = idx & 63;
        CmT[c * 136 + 2 * pp] = f2bf(p.c_re[((size_t)grp * 16 + c) * 64 + pp]); CmT[c * 136 + 2 * pp + 1] = f2bf(-p.c_im[((size_t)grp * 16 + c) * 64 + pp]); }
    __syncthreads();
    const bf16x8 zero8 = (bf16x8){0, 0, 0, 0, 0, 0, 0, 0};
    bf16x8 bfr[8], cfr[4];
#pragma unroll
    for (int nb = 0; nb < 8; ++nb) { bfr[nb] = zero8; if (g < 2) bfr[nb] = *(const LAS bf16x8*)(BmT + (16 * nb + fr) * 16 + 8 * g); }
#pragma unroll
    for (int ks = 0; ks < 4; ++ks) cfr[ks] = *(const LAS bf16x8*)(CmT + fr * 136 + 8 * g + 32 * ks);
    const float are = aTab[lane], aim = aTab[64 + lane];
    const bf16_t* U = (const bf16_t*)(p.ws + OFF_UZ) + (size_t)b * SEQ * 2048 + grp * 16;
    bf16_t* Gout = (bf16_t*)(p.ws + OFF_MIX) + (size_t)b * SEQ * 1024 + grp * 16;
    for (int ch = wid; ch < 64; ch += 8) {
        float hre = 0.f, him = 0.f;
        for (int sb = 0; sb < 4; ++sb) { const int t0 = ch * 64 + sb * 16;
            bf16x8 ua = zero8; if (g < 2) ua = *(const bf16x8*)(U + (size_t)(t0 + fr) * 2048 + 8 * g);
#pragma unroll
            for (int nb = 0; nb < 8; ++nb) { const f32x4 r = mfma16(ua, bfr[nb], (f32x4){0.f, 0.f, 0.f, 0.f});
#pragma unroll
                for (int q = 0; q < 4; ++q) BU[(4 * g + q) * 132 + 16 * nb + fr] = r[q]; }
            wave_lds_sync();
#pragma unroll
            for (int t = 0; t < 16; ++t) { const f32x2v bu = *(const LAS f32x2v*)(BU + t * 132 + 2 * lane);
                const float nre = are * hre - aim * him + bu.x, nim = are * him + aim * hre + bu.y; hre = nre; him = nim; }
            wave_lds_sync(); }
        S[ch * 128 + 2 * lane] = hre; S[ch * 128 + 2 * lane + 1] = him;
    }
    __syncthreads();
    if (wid == 0) { const float Ar = aTab[128 + lane], Ai = aTab[192 + lane]; float rre = 0.f, rim = 0.f;
        for (int ch = 0; ch < 64; ++ch) { const f32x2v s = *(const LAS f32x2v*)(S + ch * 128 + 2 * lane);
            f32x2v o; o.x = rre; o.y = rim; *(LAS f32x2v*)(S + ch * 128 + 2 * lane) = o;
            const float nre = Ar * rre - Ai * rim + s.x, nim = Ar * rim + Ai * rre + s.y; rre = nre; rim = nim; } }
    __syncthreads();
    f32x4 dsk;
#pragma unroll
    for (int q = 0; q < 4; ++q) dsk[q] = p.d_skip[grp * 16 + 4 * g + q];
    for (int ch = wid; ch < 64; ch += 8) {
        float hre = S[ch * 128 + 2 * lane], him = S[ch * 128 + 2 * lane + 1];
        for (int sb = 0; sb < 4; ++sb) { const int t0 = ch * 64 + sb * 16;
            bf16x8 ua = zero8; if (g < 2) ua = *(const bf16x8*)(U + (size_t)(t0 + fr) * 2048 + 8 * g);
#pragma unroll
            for (int nb = 0; nb < 8; ++nb) { const f32x4 r = mfma16(ua, bfr[nb], (f32x4){0.f, 0.f, 0.f, 0.f});
#pragma unroll
                for (int q = 0; q < 4; ++q) BU[(4 * g + q) * 132 + 16 * nb + fr] = r[q]; }
            wave_lds_sync();
#pragma unroll
            for (int t = 0; t < 16; ++t) { const f32x2v bu = *(const LAS f32x2v*)(BU + t * 132 + 2 * lane);
                const float nre = are * hre - aim * him + bu.x, nim = are * him + aim * hre + bu.y; hre = nre; him = nim;
                *(LAS unsigned*)(Hs + t * 136 + 2 * lane) = cvt_pk_bf16(hre, him); }
            wave_lds_sync();
            f32x4 y = (f32x4){0.f, 0.f, 0.f, 0.f};
#pragma unroll
            for (int ks = 0; ks < 4; ++ks) { const bf16x8 hb = *(const LAS bf16x8*)(Hs + fr * 136 + 8 * g + 32 * ks); y = mfma16(cfr[ks], hb, y); }
            const size_t tok = (size_t)(t0 + fr);
            const u32x2 u4 = *(const u32x2*)(U + tok * 2048 + 4 * g);
            const float o0 = gelu_f(y[0] + dsk[0] * __uint_as_float(u4.x << 16)), o1 = gelu_f(y[1] + dsk[1] * __uint_as_float(u4.x & 0xffff0000u));
            const float o2 = gelu_f(y[2] + dsk[2] * __uint_as_float(u4.y << 16)), o3 = gelu_f(y[3] + dsk[3] * __uint_as_float(u4.y & 0xffff0000u));
            u32x2 w; w.x = cvt_pk_bf16(o0, o1); w.y = cvt_pk_bf16(o2, o3);
            *(u32x2*)(Gout + tok * 1024 + 4 * g) = w;
            wave_lds_sync(); }
    }
}

template <int MODE> __device__ __forceinline__ void run_gemm(LAS unsigned char* lds, const bf16_t* A, const bf16_t* Bt, int N, int K, bf16_t* O, int ldc, const float* bias, const bf16_t* Gp, const bf16_t* UZp) {
    pg8::Gemm gm; gm.A = A; gm.Bt = Bt; gm.M = NTOK; gm.N = N; gm.K = K;
    pg8::StaticOrder S; S.init(NTOK, N, (int)gridDim.x, (int)blockIdx.x);
    pg8::EpiM<MODE> E; E.O = O; E.ldc = ldc; E.bias = bias; E.G = Gp; E.UZ = UZp; E.qscale = 0.08838834764831845f;
    pg8::gemm_phase<pg8::EpiM<MODE>, pg8::StaticOrder, true, true>(lds, gm, S, E);
}

#ifndef PHASE_MASK
#define PHASE_MASK 0x7ff
#endif
constexpr int N_PHASES = 11;
__global__ __launch_bounds__(512, 2) void mega_fwd(Params p, int ph_lo, int ph_hi) {
    extern __shared__ __attribute__((aligned(16))) unsigned char shm[];
    LAS unsigned char* lds = (LAS unsigned char*)shm;
    cg::grid_group grid = cg::this_grid();
    unsigned char* ws = p.ws;
#define PH_BEGIN(k) if (ph_lo <= (k) && (k) < ph_hi) { if ((k) > ph_lo) grid.sync(); if (PHASE_MASK & (1 << (k))) {
#define PH_END }}
    PH_BEGIN(0) phase_prep(p, lds); PH_END
    PH_BEGIN(1) phase_rows<0>(p, lds); PH_END
    PH_BEGIN(2) run_gemm<0>(lds, (const bf16_t*)(ws + OFF_HB), (const bf16_t*)(ws + OFF_W1T), 7168, 2048, (bf16_t*)(ws + OFF_PROJ), 7168, nullptr, nullptr, nullptr); PH_END
    PH_BEGIN(3) phase_mixers(p, lds); PH_END
    PH_BEGIN(4) run_gemm<1>(lds, (const bf16_t*)(ws + OFF_MIX), (const bf16_t*)(ws + OFF_W2T), 2048, 2048, (bf16_t*)(ws + OFF_Y0), 2048, nullptr, nullptr, nullptr); PH_END
    PH_BEGIN(5) phase_rows<1>(p, lds); PH_END
    PH_BEGIN(6) run_gemm<2>(lds, (const bf16_t*)(ws + OFF_HB), (const bf16_t*)(ws + OFF_W3T), 2048, 2048, (bf16_t*)(ws + OFF_UZ), 2048, nullptr, nullptr, nullptr); PH_END
    PH_BEGIN(7) for (int it = blockIdx.x; it < 256; it += gridDim.x) ssm_item(p, lds, it >> 6, it & 63); PH_END
    PH_BEGIN(8) run_gemm<3>(lds, (const bf16_t*)(ws + OFF_MIX), (const bf16_t*)(ws + OFF_W4T), 1024, 1024, (bf16_t*)(ws + OFF_MIX) + (size_t)NTOK * 1024, 1024, p.b_glu, (const bf16_t*)(ws + OFF_MIX), (const bf16_t*)(ws + OFF_UZ)); PH_END
    PH_BEGIN(9) run_gemm<1>(lds, (const bf16_t*)(ws + OFF_MIX) + (size_t)NTOK * 1024, (const bf16_t*)(ws + OFF_W5T), 2048, 1024, (bf16_t*)(ws + OFF_Y1), 2048, nullptr, nullptr, nullptr); PH_END
    PH_BEGIN(10) phase_rows<2>(p, lds); PH_END
}

extern "C" void kernel_launch(void* const* d_in, const int* in_sizes, int n_in, void* d_out, int out_size, void* d_ws, size_t ws_size, hipStream_t stream) {
    static int grid = 0;
    if (grid == 0) {
        if (n_in != 23 || out_size != NTOK * DM || ws_size < WS_END) { fprintf(stderr, "kernel_launch: unexpected shapes (n_in %d out %d ws %zu need %zu)\n", n_in, out_size, ws_size, (size_t)WS_END); grid = -1; return; }
        int dev = 0, cus = 0, per_cu = 0;
        hipGetDevice(&dev); hipDeviceGetAttribute(&cus, hipDeviceAttributeMultiprocessorCount, dev);
        if (hipFuncSetAttribute((const void*)mega_fwd, hipFuncAttributeMaxDynamicSharedMemorySize, LDS_BYTES) != hipSuccess) { fprintf(stderr, "kernel_launch: hipFuncSetAttribute failed\n"); grid = -1; return; }
        if (hipOccupancyMaxActiveBlocksPerMultiprocessor(&per_cu, (const void*)mega_fwd, 512, LDS_BYTES) != hipSuccess || per_cu < 1) { fprintf(stderr, "kernel_launch: occupancy query says %d\n", per_cu); per_cu = 1; }
        (void)hipGetLastError();
        grid = cus * 1;
        fprintf(stderr, "kernel_launch: grid %d (cus %d, per_cu %d)\n", grid, cus, per_cu);
    }
    if (grid < 0) return;
    Params p{};
    const float** pp = (const float**)&p;
    for (int i = 0; i < 23; ++i) pp[i] = (const float*)d_in[i];
    p.out = (float*)d_out; p.ws = (unsigned char*)d_ws;
#if MULTI_LAUNCH
    for (int ph = 0; ph < N_PHASES; ++ph) {
        hipLaunchKernelGGL(mega_fwd, dim3(grid), dim3(512), LDS_BYTES, stream, p, ph, ph + 1);
    }
#else
    int lo = 0, hi = N_PHASES;
    void* args[] = {(void*)&p, (void*)&lo, (void*)&hi};
    hipError_t e = hipLaunchCooperativeKernel((const void*)mega_fwd, dim3(grid), dim3(512), args, LDS_BYTES, stream);
    if (e != hipSuccess) fprintf(stderr, "cooperative launch failed: %s (grid %d)\n", hipGetErrorString(e), grid);
#endif
}
```

```cpp
#include <hip/hip_runtime.h>
#include <hip/hip_cooperative_groups.h>
#include <cstdio>
#include <cstdint>
namespace cg = cooperative_groups;

#ifndef GEMM_ALIGN
#define GEMM_ALIGN true
#endif
#ifndef GEMM_SP2
#define GEMM_SP2 true
#endif
#ifndef ATT_REP
#define ATT_REP 1
#endif
#ifndef SGU_REP
#define SGU_REP 1
#endif
#ifndef MULTI_LAUNCH
#define MULTI_LAUNCH 0
#endif

namespace pg8 {
#define PG8_LAS __attribute__((address_space(3)))
typedef unsigned short bf16_t;
typedef short bf16x8 __attribute__((ext_vector_type(8)));
typedef float f32x4 __attribute__((ext_vector_type(4)));
typedef unsigned u32x4 __attribute__((ext_vector_type(4)));
constexpr int BM = 256, BK = 64, HALF = 128, HTB = HALF * BK * 2  , STAGE_BYTES = 8 * HTB, NXCD = 8, WGM = 2;

__host__ __device__ __forceinline__ int lds_byte(int r, int c) { const int st = (r >> 4) * 2 + (c >> 5), rr = r & 15, cc = c & 31, ob = rr * 64 + cc * 2; return st * 1024 + (ob ^ (((ob >> 9) & 1) << 5)); }
__host__ __device__ __forceinline__ void stage_rc(int b, int& R, int& C) { const int st = b / 1024, sb = b % 1024, swz = sb ^ (((sb >> 9) & 1) << 5); R = (st >> 1) * 16 + swz / 64; C = (st & 1) * 32 + (swz % 64) / 2; }
__host__ __device__ __forceinline__ int perm32(int rho) { const int n = rho >> 4, i = rho & 15; return 8 * (i >> 2) + 4 * n + (i & 3); }

struct Unit { int pm, pn; };
struct Gemm { const bf16_t* A; const bf16_t* Bt; int M, N, K; };

struct StaticOrder {
    int nM, nN, nwg, G, c;
    __host__ __device__ void init(int M, int N, int G_, int c_) { nM = M / BM; nN = N / BM; nwg = nM * nN; G = G_; c = c_; }
    __host__ __device__ bool next(int i, Unit& u) const {
        const long L = (long)i * G + c; if (L >= nwg) return false;
        int wgid = (int)L; { const int q = nwg / NXCD, r = nwg % NXCD, xcd = wgid % NXCD, off = wgid / NXCD; wgid = (xcd < r ? xcd * (q + 1) : r * (q + 1) + (xcd - r) * q) + off; }
        const int nig = WGM * nN, gid = wgid / nig, fm = gid * WGM, gsz = (nM - fm) < WGM ? (nM - fm) : WGM;
        u.pm = fm + ((wgid % nig) % gsz); u.pn = (wgid % nig) / gsz; return true;
    }
    __device__ __forceinline__ void a_ready(const Unit&) const {}
    __device__ __forceinline__ void done(const Unit&) const {}
};


__device__ __forceinline__ unsigned cvt_pk_bf16(float lo, float hi) { unsigned r; asm volatile("v_cvt_pk_bf16_f32 %0, %1, %2" : "=v"(r) : "v"(lo), "v"(hi)); return r; }

template <class Epi, class Sched, bool ALIGN_EPI = false, bool SP2 = false>
__device__ __forceinline__ void gemm_phase(PG8_LAS unsigned char* lds, const Gemm g, const Sched& S, const Epi& E) {
    const int tid = threadIdx.x, wid = __builtin_amdgcn_readfirstlane(tid >> 6), lane = tid & 63, wr = wid >> 2, wc = wid & 3, fr = lane & 15, fq = lane >> 4;
    const int K = g.K, nt = K / BK;
    unsigned voffA[2], voffB[2];
#pragma unroll
    for (int i = 0; i < 2; ++i) { int R, C; stage_rc(tid * 16 + i * 8192, R, C); const int Rb = Epi::PERM ? ((R & ~31) + perm32(R & 31)) : R;
        voffA[i] = (unsigned)(R * K + C) * 2u; voffB[i] = (unsigned)(Rb * K + C) * 2u; }
    const size_t kstep = (size_t)(BK * 2);
    const size_t hstep = (size_t)HALF * K * 2;
    const size_t tstep = 2 * hstep;
    const unsigned ldsw = (unsigned)wid * 1024u;
    const int aoff = lds_byte(wr * 64 + fr, fq * 8), boff = lds_byte(wc * 32 + fr, fq * 8);
#define PG8_SA(b, h) (((b) * 2 + (h)) * HTB)
#define PG8_SB(b, h) ((4 + (b) * 2 + (h)) * HTB)
#define PG8_STAGE(bufoff, gbase, voff) do { _Pragma("unroll") for (int _i = 0; _i < 2; ++_i) \
        __builtin_amdgcn_global_load_lds((const unsigned*)((const char*)(gbase) + (voff)[_i]), (PG8_LAS unsigned*)(lds + (bufoff) + ldsw + _i * 8192), 16, 0, 0); } while (0)
#define PG8_LDA(dst, b, h) do { _Pragma("unroll") for (int m = 0; m < 4; ++m) _Pragma("unroll") for (int k = 0; k < 2; ++k) dst[m][k] = *(const PG8_LAS bf16x8*)(lds + PG8_SA(b, h) + aoff + m * 2048 + k * 1024); } while (0)
#define PG8_LDB(dst, b, h) do { _Pragma("unroll") for (int n = 0; n < 2; ++n) _Pragma("unroll") for (int k = 0; k < 2; ++k) dst[n][k] = *(const PG8_LAS bf16x8*)(lds + PG8_SB(b, h) + boff + n * 2048 + k * 1024); } while (0)
#define PG8_MMA(ai, bj, At, Bt) do { __builtin_amdgcn_s_setprio(1); _Pragma("unroll") for (int m = 0; m < 4; ++m) _Pragma("unroll") for (int n = 0; n < 2; ++n) _Pragma("unroll") for (int k = 0; k < 2; ++k) \
        acc[ai][bj][m][n] = __builtin_amdgcn_mfma_f32_16x16x32_bf16(Bt[n][k], At[m][k], acc[ai][bj][m][n], 0, 0, 0); __builtin_amdgcn_s_setprio(0); } while (0)
#define PG8_WAIT_V(n) asm volatile("s_waitcnt vmcnt(" #n ")" ::: "memory")
#define PG8_WAIT_L(n) asm volatile("s_waitcnt lgkmcnt(" #n ")" ::: "memory")
#define PG8_BAR __builtin_amdgcn_s_barrier()
#define PG8_SCHED __builtin_amdgcn_sched_barrier(0)
    Unit cur, nxt; int ui = 0;
    if (!S.next(0, cur)) return;
    f32x4 acc[2][2][4][2];
#pragma unroll
    for (int a = 0; a < 2; ++a)
#pragma unroll
        for (int b = 0; b < 2; ++b)
#pragma unroll
            for (int m = 0; m < 4; ++m)
#pragma unroll
                for (int n = 0; n < 2; ++n) acc[a][b][m][n] = (f32x4){0.f, 0.f, 0.f, 0.f};
    bf16x8 At[4][2], B0[2][2], B1[2][2];
    const char* cA = (const char*)g.A + (size_t)cur.pm * tstep; const char* cB = (const char*)g.Bt + (size_t)cur.pn * tstep;
    S.a_ready(cur);
    if constexpr (SP2) {
        PG8_STAGE(PG8_SB(0, 0), cB, voffB); PG8_STAGE(PG8_SB(0, 1), cB + hstep, voffB); PG8_STAGE(PG8_SA(0, 0), cA, voffA); PG8_STAGE(PG8_SA(0, 1), cA + hstep, voffA);
        if (wr == 1) PG8_BAR;
        PG8_WAIT_V(2); PG8_BAR;
        PG8_STAGE(PG8_SB(1, 0), cB + kstep, voffB); PG8_STAGE(PG8_SA(1, 0), cA + kstep, voffA); PG8_STAGE(PG8_SB(1, 1), cB + hstep + kstep, voffB);
        PG8_WAIT_V(6); PG8_BAR;
    } else {
        PG8_STAGE(PG8_SB(0, 0), cB, voffB); PG8_STAGE(PG8_SA(0, 0), cA, voffA); PG8_STAGE(PG8_SB(0, 1), cB + hstep, voffB); PG8_STAGE(PG8_SA(0, 1), cA + hstep, voffA);
        if (wr == 1) PG8_BAR;
        PG8_WAIT_V(4); PG8_BAR;
        PG8_STAGE(PG8_SB(1, 0), cB + kstep, voffB); PG8_STAGE(PG8_SA(1, 0), cA + kstep, voffA); PG8_STAGE(PG8_SB(1, 1), cB + hstep + kstep, voffB);
        PG8_WAIT_V(6); PG8_BAR;
    }
    for (;;) {
        const bool has_next = S.next(ui + 1, nxt);
        const char* nA = has_next ? (const char*)g.A + (size_t)nxt.pm * tstep : cA; const char* nB = has_next ? (const char*)g.Bt + (size_t)nxt.pn * tstep : cB;
        for (int t = 0; t < nt; t += 2) {
            const bool last = (t == nt - 2);
            const char* a1 = cA + (size_t)(t + 1) * kstep;
            const char* a2 = last ? nA : cA + (size_t)(t + 2) * kstep; const char* b2 = last ? nB : cB + (size_t)(t + 2) * kstep;
            const char* a3 = a2 + kstep; const char* b3 = b2 + kstep;
            if (last && has_next) S.a_ready(nxt);
            if constexpr (SP2) {
            PG8_LDB(B0, 0, 0); PG8_LDB(B1, 0, 1); PG8_SCHED; PG8_LDA(At, 0, 0); PG8_STAGE(PG8_SA(1, 1), a1 + hstep, voffA);
            PG8_WAIT_V(8); PG8_WAIT_L(0); PG8_BAR; PG8_MMA(0, 0, At, B0); PG8_MMA(0, 1, At, B1); PG8_BAR; PG8_SCHED;
            PG8_LDA(At, 0, 1); PG8_STAGE(PG8_SB(0, 0), b2, voffB); PG8_STAGE(PG8_SB(0, 1), b2 + hstep, voffB); PG8_STAGE(PG8_SA(0, 0), a2, voffA);
            PG8_WAIT_V(8); PG8_WAIT_L(0); PG8_BAR; PG8_MMA(1, 0, At, B0); PG8_MMA(1, 1, At, B1); PG8_BAR; PG8_SCHED;
            PG8_LDB(B0, 1, 0); PG8_LDB(B1, 1, 1); PG8_SCHED; PG8_LDA(At, 1, 0); PG8_STAGE(PG8_SA(0, 1), a2 + hstep, voffA);
            PG8_WAIT_V(8); PG8_WAIT_L(0); PG8_BAR; PG8_MMA(0, 0, At, B0); PG8_MMA(0, 1, At, B1); PG8_BAR; PG8_SCHED;
            PG8_LDA(At, 1, 1); PG8_STAGE(PG8_SB(1, 0), b3, voffB); PG8_STAGE(PG8_SB(1, 1), b3 + hstep, voffB); PG8_STAGE(PG8_SA(1, 0), a3, voffA);
            PG8_WAIT_V(8); PG8_WAIT_L(0); PG8_BAR; PG8_MMA(1, 0, At, B0); PG8_MMA(1, 1, At, B1); PG8_BAR; PG8_SCHED;
            } else {
            PG8_LDB(B0, 0, 0); PG8_SCHED; PG8_LDA(At, 0, 0); PG8_STAGE(PG8_SA(1, 1), a1 + hstep, voffA);
            PG8_WAIT_L(8); PG8_BAR; PG8_WAIT_L(0); PG8_MMA(0, 0, At, B0); PG8_BAR; PG8_SCHED;
            PG8_LDB(B1, 0, 1); PG8_STAGE(PG8_SB(0, 0), b2, voffB);
            PG8_BAR; PG8_WAIT_L(0); PG8_MMA(0, 1, At, B1); PG8_BAR;
            PG8_LDA(At, 0, 1); PG8_STAGE(PG8_SA(0, 0), a2, voffA);
            PG8_BAR; PG8_WAIT_L(0); PG8_MMA(1, 0, At, B0); PG8_BAR; PG8_SCHED;
            PG8_STAGE(PG8_SB(0, 1), b2 + hstep, voffB);
            PG8_WAIT_V(6); PG8_BAR; PG8_MMA(1, 1, At, B1); PG8_BAR;
            PG8_LDB(B0, 1, 0); PG8_SCHED; PG8_LDA(At, 1, 0); PG8_STAGE(PG8_SA(0, 1), a2 + hstep, voffA);
            PG8_WAIT_L(8); PG8_BAR; PG8_WAIT_L(0); PG8_MMA(0, 0, At, B0); PG8_BAR; PG8_SCHED;
            PG8_LDB(B1, 1, 1); PG8_STAGE(PG8_SB(1, 0), b3, voffB);
            PG8_BAR; PG8_WAIT_L(0); PG8_MMA(0, 1, At, B1); PG8_BAR;
            PG8_LDA(At, 1, 1); PG8_STAGE(PG8_SA(1, 0), a3, voffA);
            PG8_BAR; PG8_WAIT_L(0); PG8_MMA(1, 0, At, B0); PG8_BAR; PG8_SCHED;
            PG8_STAGE(PG8_SB(1, 1), b3 + hstep, voffB);
            PG8_WAIT_V(6); PG8_BAR; PG8_MMA(1, 1, At, B1); PG8_BAR;
            }
        }
        if constexpr (ALIGN_EPI) { if (wr == 0) PG8_BAR; }
        if constexpr (!Epi::AFTER_DRAIN) { E(acc, cur, wr, wc, fr, fq); S.done(cur); }
        if (!has_next) break;
#pragma unroll
        for (int a = 0; a < 2; ++a)
#pragma unroll
            for (int b = 0; b < 2; ++b)
#pragma unroll
                for (int m = 0; m < 4; ++m)
#pragma unroll
                    for (int n = 0; n < 2; ++n) acc[a][b][m][n] = (f32x4){0.f, 0.f, 0.f, 0.f};
        cur = nxt; cA = nA; cB = nB; ++ui;
        if constexpr (ALIGN_EPI) { if (wr == 1) PG8_BAR; }
    }
    PG8_WAIT_V(0);
    if constexpr (!ALIGN_EPI) { if (wr == 0) PG8_BAR; }
    PG8_BAR;
    if constexpr (Epi::AFTER_DRAIN) { E.fused(acc, cur, wr, wc, fr, fq, lds, wid, lane); S.done(cur); }
#undef PG8_SA
#undef PG8_SB
#undef PG8_STAGE
#undef PG8_LDA
#undef PG8_LDB
#undef PG8_MMA
#undef PG8_WAIT_V
#undef PG8_WAIT_L
#undef PG8_BAR
#undef PG8_SCHED
}

__device__ __forceinline__ float bf2f(unsigned short b) { return __uint_as_float(((unsigned)b) << 16); }
__device__ __forceinline__ unsigned short f2bf(float f) { unsigned u = __float_as_uint(f); u += 0x7FFFu + ((u >> 16) & 1u); return (unsigned short)(u >> 16); }
__device__ __forceinline__ float sigmoid_f(float x) { return __builtin_amdgcn_rcpf(1.f + __expf(-x)); }
__device__ __forceinline__ float silu_f(float x) { return x * sigmoid_f(x); }
__device__ __forceinline__ float gelu_f(float x) { const float u = 0.7978845608028654f * (x + 0.044715f * x * x * x); return x * sigmoid_f(2.f * u); }

template <int MODE> struct EpiM {
    static constexpr bool PERM = true, AFTER_DRAIN = false;
    bf16_t* O; int ldc; const float* bias; const bf16_t* G; const bf16_t* UZ; float qscale; bf16_t* UG;
    __device__ __forceinline__ void operator()(const f32x4 (&acc)[2][2][4][2], const Unit& u, int wr, int wc, int fr, int fq) const {
        const int row0 = u.pm * BM + wr * 64 + fr; const int colt = u.pn * BM; const int col0 = colt + wc * 32 + 8 * fq;
        int act = 0;
        if (MODE == 0) { const int seg = colt >> 10; act = (seg <= 1) ? 1 : ((seg == 2 || seg == 6) ? 2 : (seg == 3 ? 3 : 0)); }
        if (MODE == 2) { act = (colt >= 1024) ? 2 : 0; }
#pragma unroll
        for (int ai = 0; ai < 2; ++ai)
#pragma unroll
            for (int m = 0; m < 4; ++m) {
                const int row = row0 + ai * HALF + m * 16;
#pragma unroll
                for (int bj = 0; bj < 2; ++bj) {
                    const int col = col0 + bj * HALF;
                    float v[8];
#pragma unroll
                    for (int j = 0; j < 4; ++j) { v[j] = acc[ai][bj][m][0][j]; v[4 + j] = acc[ai][bj][m][1][j]; }
                    if (MODE == 0 || MODE == 2) {
                        if (act == 1) {
#pragma unroll
                            for (int j = 0; j < 8; ++j) v[j] = gelu_f(v[j]);
                        } else if (act == 2) {
#pragma unroll
                            for (int j = 0; j < 8; ++j) v[j] = silu_f(v[j]);
                        } else if (act == 3) {
#pragma unroll
                            for (int j = 0; j < 8; ++j) v[j] = v[j] * qscale;
                        }
                    }
                    if (MODE == 3) {
                        const f32x4 b0 = *(const f32x4*)(bias + col), b1 = *(const f32x4*)(bias + col + 4);
                        const bf16x8 gv = *(const bf16x8*)(G + (size_t)row * 1024 + col);
                        const bf16x8 zv = *(const bf16x8*)(UZ + (size_t)row * 2048 + 1024 + col);
#pragma unroll
                        for (int j = 0; j < 8; ++j) { const float t = v[j] + (j < 4 ? b0[j & 3] : b1[j & 3]); v[j] = bf2f((unsigned short)gv[j]) * sigmoid_f(t) * bf2f((unsigned short)zv[j]); }
                    }
                    u32x4 w; w.x = cvt_pk_bf16(v[0], v[1]); w.y = cvt_pk_bf16(v[2], v[3]); w.z = cvt_pk_bf16(v[4], v[5]); w.w = cvt_pk_bf16(v[6], v[7]);
                    if (MODE == 2 && colt < 1024) *(u32x4*)(UG + ((size_t)((row >> 12) * 64 + (col >> 4)) * 4096 + (row & 4095)) * 16 + (col & 15)) = w;
                    else *(u32x4*)(O + (size_t)row * ldc + col) = w;
                }
            }
    }
};
}

using pg8::bf16_t; using pg8::bf16x8; using pg8::f32x4; using pg8::u32x4; using pg8::bf2f; using pg8::f2bf; using pg8::silu_f; using pg8::gelu_f; using pg8::sigmoid_f; using pg8::cvt_pk_bf16;
#define LAS __attribute__((address_space(3)))
typedef unsigned u32x2 __attribute__((ext_vector_type(2)));
typedef float f32x2v __attribute__((ext_vector_type(2)));

constexpr int NTOK = 16384, DM = 2048, SEQ = 4096;
constexpr float EPS = 1e-6f;
constexpr int LDS_BYTES = 148480;
constexpr size_t OFF_BAR = 0;
constexpr size_t OFF_MODP = 16384;
constexpr size_t OFF_W1T = OFF_MODP + (size_t)8 * 2 * 4 * 6144 * 4;
constexpr size_t OFF_W2T = OFF_W1T + (size_t)7168 * 2048 * 2;
constexpr size_t OFF_W3T = OFF_W2T + (size_t)2048 * 2048 * 2;
constexpr size_t OFF_W4T = OFF_W3T + (size_t)2048 * 2048 * 2;
constexpr size_t OFF_W5T = OFF_W4T + (size_t)1024 * 1024 * 2;
constexpr size_t OFF_HB = OFF_W5T + (size_t)2048 * 1024 * 2;
constexpr size_t OFF_MIX = OFF_HB + (size_t)NTOK * 2048 * 2;
constexpr size_t OFF_PROJ = OFF_MIX + (size_t)NTOK * 2048 * 2;
constexpr size_t OFF_Y0 = OFF_PROJ;
constexpr size_t OFF_UZ = OFF_Y0 + (size_t)NTOK * 2048 * 2;
constexpr size_t OFF_Y1 = OFF_UZ + (size_t)NTOK * 2048 * 2;
constexpr size_t OFF_UG = OFF_Y1 + (size_t)NTOK * 2048 * 2;
constexpr size_t WS_END = OFF_PROJ + (size_t)NTOK * 7168 * 2;
static_assert(OFF_UG + (size_t)NTOK * 1024 * 2 <= WS_END, "workspace map");

struct Params {
    const float *x, *c, *ln_pre_g, *ln_post_g, *w_mod, *b_mod, *w_in_ab, *w_out_ab, *sgu_norm_g, *sgu_w, *sgu_b,
        *w_in_ssm, *w_out_ssm, *lam_re, *lam_im, *b_re, *b_im, *c_re, *c_im, *d_skip, *log_dt, *w_glu, *b_glu;
    float* out; unsigned char* ws;
};

__device__ __forceinline__ float wave_sum(float v) {
#pragma unroll
    for (int o = 1; o < 64; o <<= 1) v += __shfl_xor(v, o);
    return v;
}
__device__ __forceinline__ void wave_lds_sync() { asm volatile("s_waitcnt lgkmcnt(0)" ::: "memory"); }
typedef short s16x4 __attribute__((ext_vector_type(4)));
__device__ __forceinline__ s16x4 lds_tr16(const LAS bf16_t* p) { return __builtin_amdgcn_ds_read_tr16_b64_v4i16((LAS s16x4*)p); }
__device__ __forceinline__ bf16x8 cat4(s16x4 lo, s16x4 hi) { return __builtin_shufflevector(lo, hi, 0, 1, 2, 3, 4, 5, 6, 7); }
__device__ __forceinline__ f32x4 mfma16(bf16x8 a, bf16x8 b, f32x4 c) { return __builtin_amdgcn_mfma_f32_16x16x32_bf16(a, b, c, 0, 0, 0); }

__device__ __forceinline__ void phase_mod(const Params& p, LAS unsigned char* lds) {
    LAS float* sc = (LAS float*)lds;
    LAS float* part = sc + 8192;
    const int tid = threadIdx.x;
    for (int i = tid; i < 8192; i += 512) sc[i] = silu_f(p.c[i]);
    __syncthreads();
    float* MOD = (float*)(p.ws + OFF_MODP);
    for (int cb = blockIdx.x; cb < 256; cb += gridDim.x) {
        const int l = cb >> 7, col0 = (cb & 127) * 48, q = tid % 12, kg = tid / 12;
        if (kg < 42) {
            f32x4 acc[4];
#pragma unroll
            for (int b = 0; b < 4; ++b) acc[b] = (f32x4){0.f, 0.f, 0.f, 0.f};
            const float* W = p.w_mod + (size_t)l * 2048 * 6144 + col0 + 4 * q;
#pragma unroll 8
            for (int k = kg; k < 2048; k += 42) { const f32x4 w = __builtin_nontemporal_load((const f32x4*)(W + (size_t)k * 6144));
#pragma unroll
                for (int b = 0; b < 4; ++b) { const float sv = sc[b * 2048 + k]; acc[b] += w * sv; } }
#pragma unroll
            for (int b = 0; b < 4; ++b) *(LAS f32x4*)(part + (kg * 4 + b) * 48 + 4 * q) = acc[b];
        }
        __syncthreads();
        if (tid < 192) { const int b = tid / 48, c = tid % 48; float sm = p.b_mod[l * 6144 + col0 + c];
            for (int g2 = 0; g2 < 42; ++g2) sm += part[(g2 * 4 + b) * 48 + c];
            MOD[((size_t)l * 4 + b) * 6144 + col0 + c] = sm; }
        __syncthreads();
    }
}
__device__ __forceinline__ void transpose_item(const float* W, int K, int N, bf16_t* WT, LAS float* scr, int item, int lane) {
    const int nblk = N / 32, kb = item / nblk, nb = item % nblk, k0 = 64 * kb, n0 = 32 * nb;
#pragma unroll
    for (int i = 0; i < 32; ++i) { const int kk = 2 * i + (lane >> 5); scr[kk * 33 + (lane & 31)] = __builtin_nontemporal_load(W + (size_t)(k0 + kk) * N + n0 + (lane & 31)); }
    wave_lds_sync();
    const int c = lane & 7;
#pragma unroll
    for (int j = 0; j < 4; ++j) { const int n = (lane >> 3) + 8 * j; const LAS float* sp = scr + (8 * c) * 33 + n;
        u32x4 o; o.x = cvt_pk_bf16(sp[0 * 33], sp[1 * 33]); o.y = cvt_pk_bf16(sp[2 * 33], sp[3 * 33]); o.z = cvt_pk_bf16(sp[4 * 33], sp[5 * 33]); o.w = cvt_pk_bf16(sp[6 * 33], sp[7 * 33]);
        *(u32x4*)(WT + (size_t)(n0 + n) * K + k0 + 8 * c) = o; }
    wave_lds_sync();
}
__device__ __forceinline__ void phase_transposes(const Params& p, LAS unsigned char* lds) {
    const int tid = threadIdx.x, wid = __builtin_amdgcn_readfirstlane(tid >> 6), lane = tid & 63;
    LAS float* scr = (LAS float*)(lds + 32768 + wid * 8448);
    constexpr int I1 = 32 * 224, I2 = 32 * 64, I3 = 32 * 64, I4 = 16 * 32, I5 = 16 * 64, NITEMS = I1 + I2 + I3 + I4 + I5;
    const int gw = blockIdx.x * 8 + wid, NW = gridDim.x * 8;
    for (int it = gw; it < NITEMS; it += NW) {
        int r = it;
        if (r < I1) { transpose_item(p.w_in_ab, 2048, 7168, (bf16_t*)(p.ws + OFF_W1T), scr, r, lane); continue; } r -= I1;
        if (r < I2) { transpose_item(p.w_out_ab, 2048, 2048, (bf16_t*)(p.ws + OFF_W2T), scr, r, lane); continue; } r -= I2;
        if (r < I3) { transpose_item(p.w_in_ssm, 2048, 2048, (bf16_t*)(p.ws + OFF_W3T), scr, r, lane); continue; } r -= I3;
        if (r < I4) { transpose_item(p.w_glu, 1024, 1024, (bf16_t*)(p.ws + OFF_W4T), scr, r, lane); continue; } r -= I4;
        transpose_item(p.w_out_ssm, 1024, 2048, (bf16_t*)(p.ws + OFF_W5T), scr, r, lane);
    }
}

__device__ __forceinline__ float mod_val(const Params& p, int l, int b, int j) { return ((const float*)(p.ws + OFF_MODP))[((size_t)l * 4 + b) * 6144 + j]; }
template <int WHICH> __device__ __forceinline__ void phase_rows(const Params& p, LAS unsigned char* lds) {
    LAS float* vA = (LAS float*)lds;
    LAS float* vB = vA + 2048;
    LAS float* vG = vB + 2048;
    LAS float* vH = vG + 2048;
    const int tid = threadIdx.x, wid = __builtin_amdgcn_readfirstlane(tid >> 6), lane = tid & 63;
    bf16_t* HB = (bf16_t*)(p.ws + OFF_HB);
    for (int chunk = blockIdx.x; chunk < NTOK / 64; chunk += gridDim.x) {
        const int row0 = chunk * 64, b = row0 >> 12;
        __syncthreads();
        for (int j = tid; j < 2048; j += 512) {
            if (WHICH == 0) { vA[j] = p.ln_pre_g[j] * (1.f + mod_val(p, 0, b, 2048 + j)); vB[j] = mod_val(p, 0, b, j); }
            if (WHICH == 1) { vG[j] = mod_val(p, 0, b, 4096 + j) * p.ln_post_g[j]; vA[j] = p.ln_pre_g[2048 + j] * (1.f + mod_val(p, 1, b, 2048 + j)); vB[j] = mod_val(p, 1, b, j); }
            if (WHICH == 2) { vG[j] = mod_val(p, 0, b, 4096 + j) * p.ln_post_g[j]; vH[j] = mod_val(p, 1, b, 4096 + j) * p.ln_post_g[2048 + j]; }
        }
        __syncthreads();
        for (int r = wid; r < 64; r += 8) {
            const size_t row = (size_t)(row0 + r);
            f32x4 xv[8];
#pragma unroll
            for (int j = 0; j < 8; ++j) xv[j] = (WHICH == 2) ? __builtin_nontemporal_load((const f32x4*)(p.x + row * 2048 + (lane + 64 * j) * 4)) : *(const f32x4*)(p.x + row * 2048 + (lane + 64 * j) * 4);
#pragma unroll
            for (int pass = 0; pass < 2; ++pass) {
                if (WHICH == 0 || (WHICH == 1 && pass == 1)) continue;
                const bf16_t* Y = (const bf16_t*)(p.ws + (pass == 0 ? OFF_Y0 : OFF_Y1));
                LAS float* gvec = (pass == 0) ? vG : vH;
                f32x4 yv[8]; float ssy = 0.f;
#pragma unroll
                for (int j = 0; j < 8; ++j) { const u32x2 w = (WHICH == 2) ? __builtin_nontemporal_load((const u32x2*)(Y + row * 2048 + (lane + 64 * j) * 4)) : *(const u32x2*)(Y + row * 2048 + (lane + 64 * j) * 4);
                    yv[j][0] = __uint_as_float(w.x << 16); yv[j][1] = __uint_as_float(w.x & 0xffff0000u); yv[j][2] = __uint_as_float(w.y << 16); yv[j][3] = __uint_as_float(w.y & 0xffff0000u);
                    ssy += yv[j][0] * yv[j][0] + yv[j][1] * yv[j][1] + yv[j][2] * yv[j][2] + yv[j][3] * yv[j][3]; }
                const float ry = rsqrtf(wave_sum(ssy) * (1.f / 2048.f) + EPS);
#pragma unroll
                for (int j = 0; j < 8; ++j) { const f32x4 gv = *(const LAS f32x4*)(gvec + (lane + 64 * j) * 4);
#pragma unroll
                    for (int e = 0; e < 4; ++e) xv[j][e] += gv[e] * (yv[j][e] * ry); }
            }
            if (WHICH == 2) {
#pragma unroll
                for (int j = 0; j < 8; ++j) __builtin_nontemporal_store(xv[j], (f32x4*)(p.out + row * 2048 + (lane + 64 * j) * 4));
            } else {
                float ss = 0.f;
#pragma unroll
                for (int j = 0; j < 8; ++j) ss += xv[j][0] * xv[j][0] + xv[j][1] * xv[j][1] + xv[j][2] * xv[j][2] + xv[j][3] * xv[j][3];
                const float rx = rsqrtf(wave_sum(ss) * (1.f / 2048.f) + EPS);
#pragma unroll
                for (int j = 0; j < 8; ++j) { const f32x4 av = *(const LAS f32x4*)(vA + (lane + 64 * j) * 4), bv = *(const LAS f32x4*)(vB + (lane + 64 * j) * 4);
                    u32x2 w; w.x = cvt_pk_bf16(xv[j][0] * rx * av[0] + bv[0], xv[j][1] * rx * av[1] + bv[1]); w.y = cvt_pk_bf16(xv[j][2] * rx * av[2] + bv[2], xv[j][3] * rx * av[3] + bv[3]);
                    *(u32x2*)(HB + row * 2048 + (lane + 64 * j) * 4) = w; }
            }
        }
    }
}

__device__ __forceinline__ void sgu_item(const Params& p, LAS unsigned char* lds, int b, int n, int h) {
    LAS bf16_t* Ws = (LAS bf16_t*)lds;
    LAS bf16_t* Vn = Ws + 128 * 136;
    const int tid = threadIdx.x, wid = __builtin_amdgcn_readfirstlane(tid >> 6), lane = tid & 63, fr = lane & 15, g = lane >> 4;
    const bf16_t* P = (const bf16_t*)(p.ws + OFF_PROJ);
    bf16_t* MIX = (bf16_t*)(p.ws + OFF_MIX);
    const size_t tok0 = (size_t)b * SEQ + (size_t)n * 128;
    __syncthreads();
    const float* Wg = p.sgu_w + (size_t)h * 16384;
#pragma unroll
    for (int i = 0; i < 8; ++i) { const int idx = tid + 512 * i, r = idx >> 5, c4 = (idx & 31) * 4;
        f32x4 w = *(const f32x4*)(Wg + r * 128 + c4);
        w[0] = (c4 + 0 <= r) ? w[0] : 0.f; w[1] = (c4 + 1 <= r) ? w[1] : 0.f; w[2] = (c4 + 2 <= r) ? w[2] : 0.f; w[3] = (c4 + 3 <= r) ? w[3] : 0.f;
        u32x2 o; o.x = cvt_pk_bf16(w[0], w[1]); o.y = cvt_pk_bf16(w[2], w[3]);
        *(LAS u32x2*)(Ws + r * 136 + c4) = o; }
    {
        const int s = tid >> 2, q4 = tid & 3;
        const bf16_t* src = P + (tok0 + s) * 7168 + 1024 + h * 128 + q4 * 32;
        bf16x8 v[4]; float ss = 0.f;
#pragma unroll
        for (int i = 0; i < 4; ++i) { v[i] = *(const bf16x8*)(src + 8 * i);
#pragma unroll
            for (int j = 0; j < 8; ++j) { const float f = bf2f((unsigned short)v[i][j]); ss += f * f; } }
        ss += __shfl_xor(ss, 1); ss += __shfl_xor(ss, 2);
        const float rn = rsqrtf(ss * (1.f / 128.f) + EPS);
#pragma unroll
        for (int i = 0; i < 4; ++i) { const int d0 = q4 * 32 + 8 * i; const f32x4 g0 = *(const f32x4*)(p.sgu_norm_g + h * 128 + d0), g1 = *(const f32x4*)(p.sgu_norm_g + h * 128 + d0 + 4);
            u32x4 o; o.x = cvt_pk_bf16(bf2f((unsigned short)v[i][0]) * rn * g0[0], bf2f((unsigned short)v[i][1]) * rn * g0[1]); o.y = cvt_pk_bf16(bf2f((unsigned short)v[i][2]) * rn * g0[2], bf2f((unsigned short)v[i][3]) * rn * g0[3]);
            o.z = cvt_pk_bf16(bf2f((unsigned short)v[i][4]) * rn * g1[0], bf2f((unsigned short)v[i][5]) * rn * g1[1]); o.w = cvt_pk_bf16(bf2f((unsigned short)v[i][6]) * rn * g1[2], bf2f((unsigned short)v[i][7]) * rn * g1[3]);
            *(LAS u32x4*)(Vn + s * 144 + d0) = o; }
    }
    const int t = 16 * wid + fr; const size_t tok = tok0 + t; const float bs = p.sgu_b[h * 128 + t];
    u32x2 gur[8], szr[8];
#pragma unroll
    for (int db = 0; db < 8; ++db) { const int col = h * 128 + 16 * db + 4 * g; gur[db] = *(const u32x2*)(P + tok * 7168 + col); szr[db] = *(const u32x2*)(P + tok * 7168 + 2048 + col); }
    __syncthreads();
    const int nks = (wid >> 1) + 1;
    f32x4 acc[8];
#pragma unroll
    for (int db = 0; db < 8; ++db) acc[db] = (f32x4){0.f, 0.f, 0.f, 0.f};
#pragma unroll
    for (int ks = 0; ks < 4; ++ks) {
        if (ks < nks) {
            const LAS bf16_t* wp = Ws + (16 * wid + fr) * 136 + 32 * ks + 4 * g;
            const u32x2 wlo = *(const LAS u32x2*)wp, whi = *(const LAS u32x2*)(wp + 16);
            u32x4 wv; wv.x = wlo.x; wv.y = wlo.y; wv.z = whi.x; wv.w = whi.y;
            const bf16x8 bfrag = __builtin_bit_cast(bf16x8, wv);
#pragma unroll
            for (int db = 0; db < 8; ++db) { const LAS bf16_t* vb = Vn + (32 * ks + 4 * g + (fr >> 2)) * 144 + 16 * db + 4 * (fr & 3);
                acc[db] = mfma16(cat4(lds_tr16(vb), lds_tr16(vb + 16 * 144)), bfrag, acc[db]); }
        }
    }
#pragma unroll
    for (int db = 0; db < 8; ++db) { const int col = h * 128 + 16 * db + 4 * g;
        const u32x2 gu = gur[db], sz = szr[db];
        const float o0 = __uint_as_float(gu.x << 16) * (acc[db][0] + bs) * __uint_as_float(sz.x << 16);
        const float o1 = __uint_as_float(gu.x & 0xffff0000u) * (acc[db][1] + bs) * __uint_as_float(sz.x & 0xffff0000u);
        const float o2 = __uint_as_float(gu.y << 16) * (acc[db][2] + bs) * __uint_as_float(sz.y << 16);
        const float o3 = __uint_as_float(gu.y & 0xffff0000u) * (acc[db][3] + bs) * __uint_as_float(sz.y & 0xffff0000u);
        u32x2 w; w.x = cvt_pk_bf16(o0, o1); w.y = cvt_pk_bf16(o2, o3);
        *(u32x2*)(MIX + tok * 2048 + col) = w; }
}

__device__ __forceinline__ void attn_wave_item(const Params& p, LAS unsigned char* wl, int b, int h, int qblk) {
    LAS bf16_t* Kw = (LAS bf16_t*)wl;
    LAS bf16_t* Vw = Kw + 32 * 144;
    const int lane = threadIdx.x & 63, fr = lane & 15, g = lane >> 4;
    const bf16_t* P = (const bf16_t*)(p.ws + OFF_PROJ);
    bf16_t* MIX = (bf16_t*)(p.ws + OFF_MIX);
    const size_t tokb = (size_t)b * SEQ;
    const int qrow0 = qblk * 32 + fr;
    bf16x8 qf[2][4];
#pragma unroll
    for (int c = 0; c < 2; ++c) { const bf16_t* qp = P + (tokb + qrow0 + 16 * c) * 7168 + 3072 + h * 128 + 8 * g;
#pragma unroll
      for (int ks = 0; ks < 4; ++ks) qf[c][ks] = *(const bf16x8*)(qp + 32 * ks); }
    f32x4 oacc[2][8];
#pragma unroll
    for (int c = 0; c < 2; ++c)
#pragma unroll
        for (int db = 0; db < 8; ++db) oacc[c][db] = (f32x4){0.f, 0.f, 0.f, 0.f};
    float carry0 = 1.f, carry1 = 1.f;
    const int lrow = lane >> 4, ld8 = (lane & 15) * 8;
    bf16x8 kreg[8], vreg[8];
#define AW_LOAD(kt_) do { const bf16_t* base_ = P + (tokb + (size_t)(kt_) * 32 + lrow) * 7168 + h * 128 + ld8; \
        _Pragma("unroll") for (int i_ = 0; i_ < 8; ++i_) { kreg[i_] = *(const bf16x8*)(base_ + (size_t)(4 * i_) * 7168 + 4096); vreg[i_] = *(const bf16x8*)(base_ + (size_t)(4 * i_) * 7168 + 5120); } } while (0)
    AW_LOAD(qblk);
    for (int kt = qblk; kt >= 0; --kt) {
#pragma unroll
        for (int i = 0; i < 8; ++i) { *(LAS bf16x8*)(Kw + (lrow + 4 * i) * 144 + ld8) = kreg[i]; *(LAS bf16x8*)(Vw + (lrow + 4 * i) * 144 + ld8) = vreg[i]; }
        if (kt > 0) AW_LOAD(kt - 1);
        wave_lds_sync();
        bf16x8 pf[2];
#pragma unroll
        for (int c = 0; c < 2; ++c) { const int qrow = qrow0 + 16 * c; float cy = c ? carry1 : carry0;
            f32x4 s0 = (f32x4){0.f, 0.f, 0.f, 0.f}, s1 = (f32x4){0.f, 0.f, 0.f, 0.f};
#pragma unroll
            for (int ks = 0; ks < 4; ++ks) { s0 = mfma16(*(const LAS bf16x8*)(Kw + fr * 144 + 8 * g + 32 * ks), qf[c][ks], s0); s1 = mfma16(*(const LAS bf16x8*)(Kw + (16 + fr) * 144 + 8 * g + 32 * ks), qf[c][ks], s1); }
            float w[2][4];
#pragma unroll
            for (int kk = 0; kk < 2; ++kk) { const int kb = 1 - kk; const f32x4 sv = kb ? s1 : s0;
                float be[4], kp[4];
#pragma unroll
                for (int r = 0; r < 4; ++r) { const float z = sv[r]; const int kpos = kt * 32 + 16 * kb + 4 * g + r;
                    const float e = __builtin_amdgcn_exp2f(fminf(z, 80.f)); const float k1 = __builtin_amdgcn_rcpf(1.f + e);
                    const bool ok = kpos < qrow; kp[r] = ok ? k1 : 1.f; be[r] = ok ? e * k1 : 0.f; }
                const float x2 = kp[3], x1 = x2 * kp[2], x0 = x1 * kp[1], tot = x0 * kp[0];
                const float p16 = __shfl_xor(tot, 16), a1 = tot * p16, po = __shfl_xor(a1, 32);
                const float base = cy * ((g & 1) ? 1.f : p16) * ((g < 2) ? po : 1.f);
                w[kb][0] = be[0] * (base * x0); w[kb][1] = be[1] * (base * x1); w[kb][2] = be[2] * (base * x2); w[kb][3] = be[3] * base;
                cy *= a1 * po;
            }
            if (c) carry1 = cy; else carry0 = cy;
            u32x4 pw; pw.x = cvt_pk_bf16(w[0][0], w[0][1]); pw.y = cvt_pk_bf16(w[0][2], w[0][3]); pw.z = cvt_pk_bf16(w[1][0], w[1][1]); pw.w = cvt_pk_bf16(w[1][2], w[1][3]);
            pf[c] = __builtin_bit_cast(bf16x8, pw);
        }
#pragma unroll
        for (int db = 0; db < 8; ++db) { const LAS bf16_t* vb = Vw + (4 * g + (fr >> 2)) * 144 + 16 * db + 4 * (fr & 3);
            const bf16x8 av = cat4(lds_tr16(vb), lds_tr16(vb + 16 * 144));
            oacc[0][db] = mfma16(av, pf[0], oacc[0][db]); oacc[1][db] = mfma16(av, pf[1], oacc[1][db]); }
        if (__all((carry0 == 0.f) && (carry1 == 0.f))) break;
        wave_lds_sync();
    }
#undef AW_LOAD
#pragma unroll
    for (int c = 0; c < 2; ++c) { const size_t tok = tokb + qrow0 + 16 * c;
#pragma unroll
        for (int db = 0; db < 8; ++db) { const int col = h * 128 + 16 * db + 4 * g;
            const u32x2 sz = *(const u32x2*)(P + tok * 7168 + 6144 + col);
            u32x2 w; w.x = cvt_pk_bf16(oacc[c][db][0] * __uint_as_float(sz.x << 16), oacc[c][db][1] * __uint_as_float(sz.x & 0xffff0000u));
            w.y = cvt_pk_bf16(oacc[c][db][2] * __uint_as_float(sz.y << 16), oacc[c][db][3] * __uint_as_float(sz.y & 0xffff0000u));
            *(u32x2*)(MIX + tok * 2048 + 1024 + col) = w; } }
}

__device__ __forceinline__ void phase_mixers(const Params& p, LAS unsigned char* lds) {
    const int G = gridDim.x, wid = __builtin_amdgcn_readfirstlane(threadIdx.x >> 6);
    const int vcu = (G == 256) ? (int)((blockIdx.x & 7) * 32 + (blockIdx.x >> 3)) : (int)blockIdx.x;
    for (int rp_ = 0; rp_ < ATT_REP; ++rp_)
    for (int i = vcu; i < 512; i += G) { const int bh = i >> 4, qb = i & 15; attn_wave_item(p, lds + wid * 18432, bh >> 3, bh & 7, qb * 8 + wid); }
    for (int rp_ = 0; rp_ < SGU_REP; ++rp_)
    for (int i = blockIdx.x; i < 1024; i += G) sgu_item(p, lds, i >> 8, (i >> 3) & 31, i & 7);
}

__device__ __forceinline__ void ssm_coef(const Params& p, int grp, int pp, float& are, float& aim, float& cre, float& cim) {
    const float dt = expf(p.log_dt[grp]); const float lr = p.lam_re[grp * 64 + pp], li = p.lam_im[grp * 64 + pp];
    const float mag = expf(lr * dt); are = mag * cosf(li * dt); aim = mag * sinf(li * dt);
    const float den = lr * lr + li * li, nr = are - 1.f;
    cre = (nr * lr + aim * li) / den; cim = (aim * lr - nr * li) / den;
}
__device__ __forceinline__ void ssm_item(const Params& p, LAS unsigned char* lds, int b, int grp) {
    LAS float* aTab = (LAS float*)lds;
    LAS bf16_t* BmN = (LAS bf16_t*)(lds + 1024);
    LAS bf16_t* CmT = (LAS bf16_t*)(lds + 5376);
    LAS float* S = (LAS float*)(lds + 9728);
    LAS bf16_t* Kt = (LAS bf16_t*)(lds + 42496);
    LAS float* AP = (LAS float*)(lds + 75776);
    const int tid = threadIdx.x, wid = __builtin_amdgcn_readfirstlane(tid >> 6), lane = tid & 63, fr = lane & 15, g = lane >> 4;
    __syncthreads();
    if (tid < 64) { float are, aim, cre, cim; ssm_coef(p, grp, tid, are, aim, cre, cim); aTab[tid] = are; aTab[64 + tid] = aim;
        float pr = are, pi = aim;
#pragma unroll
        for (int i = 0; i < 6; ++i) { const float nr2 = pr * pr - pi * pi, ni2 = 2.f * pr * pi; pr = nr2; pi = ni2; }
        aTab[128 + tid] = pr; aTab[192 + tid] = pi; }
    if (tid < 128) ((LAS unsigned*)Kt)[tid] = 0u;
#pragma unroll
    for (int i = 0; i < 2; ++i) { const int idx = tid + 512 * i, pp = idx >> 4, c = idx & 15; float are, aim, cre, cim; ssm_coef(p, grp, pp, are, aim, cre, cim);
        const float br = p.b_re[((size_t)grp * 64 + pp) * 16 + c], bi = p.b_im[((size_t)grp * 64 + pp) * 16 + c];
        BmN[c * 136 + 2 * pp] = f2bf(cre * br - cim * bi); BmN[c * 136 + 2 * pp + 1] = f2bf(cre * bi + cim * br); }
#pragma unroll
    for (int i = 0; i < 2; ++i) { const int idx = tid + 512 * i, c = idx >> 6, pp = idx & 63;
        CmT[c * 136 + 2 * pp] = f2bf(p.c_re[((size_t)grp * 16 + c) * 64 + pp]); CmT[c * 136 + 2 * pp + 1] = f2bf(-p.c_im[((size_t)grp * 16 + c) * 64 + pp]); }
    {
        const int pp = tid & 63, j8 = tid >> 6; float are, aim, cre, cim; ssm_coef(p, grp, pp, are, aim, cre, cim);
        float cr = 1.f, ci = 0.f;
        for (int i = 0; i < 8 * j8; ++i) { const float nr = cr * are - ci * aim, ni = cr * aim + ci * are; cr = nr; ci = ni; }
        if (j8 == 0) { AP[2 * pp] = 1.f; AP[2 * pp + 1] = 0.f; }
#pragma unroll
        for (int i = 1; i <= 8; ++i) { const float nr = cr * are - ci * aim, ni = cr * aim + ci * are; cr = nr; ci = ni; AP[((8 * j8 + i) * 64 + pp) * 2] = cr; AP[((8 * j8 + i) * 64 + pp) * 2 + 1] = ci; }
    }
    __syncthreads();
    bf16x8 cfr[4];
#pragma unroll
    for (int ks = 0; ks < 4; ++ks) cfr[ks] = *(const LAS bf16x8*)(CmT + fr * 136 + 8 * g + 32 * ks);
    const bf16_t* U = (const bf16_t*)(p.ws + OFF_UG) + (size_t)(b * 64 + grp) * 4096 * 16;
    bf16_t* Gout = (bf16_t*)(p.ws + OFF_MIX) + (size_t)b * SEQ * 1024 + grp * 16;
    const int th = g >> 1, c0 = 8 * (g & 1);
    const int cbw = wid & 3, hh = wid >> 2;
    {
        for (int qh = 0; qh < 2; ++qh) {
        float X[2][8], Y[2][8], a2r[2], a2i[2], apr[2], api[2];
#pragma unroll
        for (int q = 0; q < 2; ++q) { const int pl = 8 * (4 * hh + 2 * qh + q) + (fr >> 1), ri = fr & 1;
            const float are_l = aTab[pl], aim_l = aTab[64 + pl];
#pragma unroll
            for (int j = 0; j < 8; ++j) { const float bbre = bf2f(BmN[(c0 + j) * 136 + 2 * pl]), bbim = bf2f(BmN[(c0 + j) * 136 + 2 * pl + 1]);
                X[q][j] = ri ? bbim : bbre; Y[q][j] = ri ? bbre : -bbim; }
            a2r[q] = are_l * are_l - aim_l * aim_l; a2i[q] = 2.f * are_l * aim_l;
            apr[q] = th ? 1.f : are_l; api[q] = th ? 0.f : aim_l; }
        f32x4 sacc[2];
#pragma unroll
        for (int q = 0; q < 2; ++q) sacc[q] = (f32x4){0.f, 0.f, 0.f, 0.f};
#pragma unroll 4
        for (int ks = 31; ks >= 0; --ks) {
            const bf16x8 bf = *(const bf16x8*)(U + (size_t)(64 * (16 * cbw + fr) + 2 * ks + th) * 16 + c0);
#pragma unroll
            for (int q = 0; q < 2; ++q) {
                u32x4 aw; aw.x = cvt_pk_bf16(apr[q] * X[q][0] + api[q] * Y[q][0], apr[q] * X[q][1] + api[q] * Y[q][1]); aw.y = cvt_pk_bf16(apr[q] * X[q][2] + api[q] * Y[q][2], apr[q] * X[q][3] + api[q] * Y[q][3]);
                aw.z = cvt_pk_bf16(apr[q] * X[q][4] + api[q] * Y[q][4], apr[q] * X[q][5] + api[q] * Y[q][5]); aw.w = cvt_pk_bf16(apr[q] * X[q][6] + api[q] * Y[q][6], apr[q] * X[q][7] + api[q] * Y[q][7]);
                sacc[q] = mfma16(__builtin_bit_cast(bf16x8, aw), bf, sacc[q]);
                const float nr = apr[q] * a2r[q] - api[q] * a2i[q], ni = apr[q] * a2i[q] + api[q] * a2r[q]; apr[q] = nr; api[q] = ni; }
        }
#pragma unroll
        for (int q = 0; q < 2; ++q) *(LAS f32x4*)(S + (16 * cbw + fr) * 128 + 16 * (4 * hh + 2 * qh + q) + 4 * g) = sacc[q];
        }
    }
    {
        float cr[4][4], ci[4][4];
#pragma unroll
        for (int ks = 0; ks < 4; ++ks)
#pragma unroll
            for (int jp = 0; jp < 4; ++jp) { const int pp = 16 * ks + 4 * g + jp; cr[ks][jp] = p.c_re[((size_t)grp * 16 + fr) * 64 + pp]; ci[ks][jp] = p.c_im[((size_t)grp * 16 + fr) * 64 + pp]; }
        bf16x8 bmf[4];
#pragma unroll
        for (int ks = 0; ks < 4; ++ks) bmf[ks] = *(const LAS bf16x8*)(BmN + fr * 136 + 8 * g + 32 * ks);
        for (int li = 0; li < 8; ++li) { const int l = 8 * wid + li;
            f32x4 kacc = (f32x4){0.f, 0.f, 0.f, 0.f};
#pragma unroll
            for (int ks = 0; ks < 4; ++ks) { const LAS f32x4* ap = (const LAS f32x4*)(AP + (l * 64 + 16 * ks + 4 * g) * 2);
                const f32x4 p01 = ap[0], p23 = ap[1];
                const float pr[4] = {p01[0], p01[2], p23[0], p23[2]}, pi[4] = {p01[1], p01[3], p23[1], p23[3]};
                float v[8];
#pragma unroll
                for (int jp = 0; jp < 4; ++jp) { v[2 * jp] = cr[ks][jp] * pr[jp] - ci[ks][jp] * pi[jp]; v[2 * jp + 1] = -(cr[ks][jp] * pi[jp] + ci[ks][jp] * pr[jp]); }
                u32x4 aw; aw.x = cvt_pk_bf16(v[0], v[1]); aw.y = cvt_pk_bf16(v[2], v[3]); aw.z = cvt_pk_bf16(v[4], v[5]); aw.w = cvt_pk_bf16(v[6], v[7]);
                kacc = mfma16(__builtin_bit_cast(bf16x8, aw), bmf[ks], kacc); }
#pragma unroll
            for (int q = 0; q < 4; ++q) Kt[(l + 1) * 256 + (4 * g + q) * 16 + fr] = f2bf(kacc[q]);
        }
    }
    __syncthreads();
    if (wid == 0) { const float Ar = aTab[128 + lane], Ai = aTab[192 + lane]; float rre = 0.f, rim = 0.f;
        for (int ch = 0; ch < 64; ++ch) { const f32x2v sv = *(const LAS f32x2v*)(S + ch * 128 + 2 * lane);
            f32x2v o; o.x = rre; o.y = rim; *(LAS f32x2v*)(S + ch * 128 + 2 * lane) = o;
            const float nre = Ar * rre - Ai * rim + sv.x, nim = Ar * rim + Ai * rre + sv.y; rre = nre; rim = nim; } }
    __syncthreads();
    f32x4 dsk;
#pragma unroll
    for (int q = 0; q < 4; ++q) dsk[q] = p.d_skip[grp * 16 + 4 * g + q];
    f32x4 h01[4], h23[4];
#pragma unroll
    for (int ks = 0; ks < 4; ++ks) { const LAS f32x4* hp = (const LAS f32x4*)(S + (16 * cbw + fr) * 128 + 32 * ks + 8 * g); h01[ks] = hp[0]; h23[ks] = hp[1]; }
    for (int g4 = 0; g4 < 4; ++g4) {
        f32x4 acc[8];
#pragma unroll
        for (int ii = 0; ii < 8; ++ii) acc[ii] = (f32x4){0.f, 0.f, 0.f, 0.f};
#pragma unroll
        for (int ii = 0; ii < 8; ++ii) { const int t = 2 * (8 * g4 + ii) + hh;
#pragma unroll
            for (int ks = 0; ks < 4; ++ks) { const LAS f32x4* ap = (const LAS f32x4*)(AP + ((t + 1) * 64 + 16 * ks + 4 * g) * 2);
                const f32x4 p01 = ap[0], p23 = ap[1];
                u32x4 hw;
                hw.x = cvt_pk_bf16(p01[0] * h01[ks][0] - p01[1] * h01[ks][1], p01[0] * h01[ks][1] + p01[1] * h01[ks][0]);
                hw.y = cvt_pk_bf16(p01[2] * h01[ks][2] - p01[3] * h01[ks][3], p01[2] * h01[ks][3] + p01[3] * h01[ks][2]);
                hw.z = cvt_pk_bf16(p23[0] * h23[ks][0] - p23[1] * h23[ks][1], p23[0] * h23[ks][1] + p23[1] * h23[ks][0]);
                hw.w = cvt_pk_bf16(p23[2] * h23[ks][2] - p23[3] * h23[ks][3], p23[2] * h23[ks][3] + p23[3] * h23[ks][2]);
                acc[ii] = mfma16(cfr[ks], __builtin_bit_cast(bf16x8, hw), acc[ii]); } }
        const int nks = 8 * g4 + 8;
#pragma unroll 2
        for (int ks2 = 0; ks2 < nks; ++ks2) {
            const bf16x8 ub = *(const bf16x8*)(U + (size_t)(64 * (16 * cbw + fr) + 2 * ks2 + th) * 16 + c0);
#pragma unroll
            for (int ii = 0; ii < 8; ++ii) { const int t = 2 * (8 * g4 + ii) + hh;
                int li = t - (2 * ks2 + th) + 1; li = li < 0 ? 0 : li;
                const bf16x8 kf = *(const LAS bf16x8*)(Kt + li * 256 + fr * 16 + c0);
                acc[ii] = mfma16(kf, ub, acc[ii]); }
        }
#pragma unroll
        for (int ii = 0; ii < 8; ++ii) { const int t = 2 * (8 * g4 + ii) + hh; const size_t tok = (size_t)(64 * (16 * cbw + fr) + t);
            const u32x2 u4 = *(const u32x2*)(U + tok * 16 + 4 * g);
            const float o0 = gelu_f(acc[ii][0] + dsk[0] * __uint_as_float(u4.x << 16)), o1 = gelu_f(acc[ii][1] + dsk[1] * __uint_as_float(u4.x & 0xffff0000u));
            const float o2 = gelu_f(acc[ii][2] + dsk[2] * __uint_as_float(u4.y << 16)), o3 = gelu_f(acc[ii][3] + dsk[3] * __uint_as_float(u4.y & 0xffff0000u));
            u32x2 w; w.x = cvt_pk_bf16(o0, o1); w.y = cvt_pk_bf16(o2, o3);
            *(u32x2*)(Gout + tok * 1024 + 4 * g) = w; }
    }
}

#define XB_TMO      128
#define XB_XCNT(j)  (256  + 64 * (j))
#define XB_XSUB(j)  (1280 + 64 * (j))
#define XB_XGEN(j)  (2304 + 64 * (j))
#define XB_TOP      3328
#define XB_TOPGEN   3392
#define XCD_BAR_WORDS 3456
#define XB_SPIN_CAP (1u << 18)

__device__ __forceinline__ unsigned xb_ld(unsigned* p)              { return __hip_atomic_load(p, __ATOMIC_RELAXED, __HIP_MEMORY_SCOPE_AGENT); }
__device__ __forceinline__ unsigned xb_add(unsigned* p, unsigned v) { return __hip_atomic_fetch_add(p, v, __ATOMIC_RELAXED, __HIP_MEMORY_SCOPE_AGENT); }
__device__ __forceinline__ unsigned xb_xcc_id() { return (unsigned)__builtin_amdgcn_s_getreg((3 << 11) | 20) & 0xFu; }
#define XB_SPIN(cond, bar) do { unsigned _sp = 0; while (cond) { __builtin_amdgcn_s_sleep(1); \
    if ((++_sp & 255u) == 0u) { if (xb_ld(&(bar)[XB_TMO])) break; if (_sp > XB_SPIN_CAP) { atomicAdd(&(bar)[XB_TMO], 1u); break; } } } } while (0)

struct XcdBarrier {
    unsigned* bar; unsigned x;
    volatile LAS unsigned* st;
};

__device__ __forceinline__ XcdBarrier xcd_barrier_post(unsigned* bar, volatile LAS unsigned* st) {
    XcdBarrier b; b.bar = bar; b.x = xb_xcc_id(); b.st = st;
    if (threadIdx.x == 0) (void)xb_add(&bar[XB_XCNT(b.x)], 1u);
    return b;
}
__device__ __forceinline__ void xcd_barrier_complete(unsigned* bar, unsigned x, unsigned& nloc, unsigned& nx) {
    const unsigned G = gridDim.x * gridDim.y * gridDim.z;
    unsigned sum, cnt, mine, sp = 0u;
    for (;;) {
        sum = 0u; cnt = 0u; mine = 0u;
#pragma unroll
        for (unsigned j = 0; j < 16; ++j) { const unsigned c = xb_ld(&bar[XB_XCNT(j)]); sum += c; cnt += (c > 0u) ? 1u : 0u; mine = (j == x) ? c : mine; }
        if (sum == G) break;
        __builtin_amdgcn_s_sleep(1);
        if ((++sp & 255u) == 0u) { if (xb_ld(&bar[XB_TMO])) break; if (sp > XB_SPIN_CAP) { atomicAdd(&bar[XB_TMO], 1u); break; } }
    }
    nloc = mine > 0u ? mine : 1u; nx = cnt > 0u ? cnt : 1u;
}

__device__ __forceinline__ void xcd_barrier(const XcdBarrier& b) {
    asm volatile("s_waitcnt vmcnt(0)" ::: "memory");
    __syncthreads();
    if (threadIdx.x == 0) {
        unsigned* bar = b.bar;
        __builtin_amdgcn_s_waitcnt(0);
        unsigned nloc = b.st[0], nx = b.st[1];
        if (nloc == 0u) { xcd_barrier_complete(bar, b.x, nloc, nx); b.st[0] = nloc; b.st[1] = nx; }
        const unsigned old = xb_add(&bar[XB_XSUB(b.x)], 1u);
        const unsigned gen = old / nloc;
        if (old + 1u == (gen + 1u) * nloc) {
            __builtin_amdgcn_fence(__ATOMIC_RELEASE, "agent");
            asm volatile("s_waitcnt vmcnt(0)" ::: "memory");
            const unsigned og = xb_add(&bar[XB_TOP], 1u);
            const unsigned tg = og / nx;
            if (og + 1u == (tg + 1u) * nx) xb_add(&bar[XB_TOPGEN], 1u);
            else XB_SPIN(xb_ld(&bar[XB_TOPGEN]) == tg, bar);
            __builtin_amdgcn_fence(__ATOMIC_ACQUIRE, "agent");
            xb_add(&bar[XB_XGEN(b.x)], 1u);
            asm volatile("s_waitcnt vmcnt(0)" ::: "memory");
        } else {
            XB_SPIN(xb_ld(&bar[XB_XGEN(b.x)]) == gen, bar);
            __builtin_amdgcn_fence(__ATOMIC_ACQUIRE, "agent");
            asm volatile("s_waitcnt vmcnt(0)" ::: "memory");
        }
    }
    __syncthreads();
}


template <int MODE> __device__ __forceinline__ void run_gemm(unsigned char* ws_, LAS unsigned char* lds, const bf16_t* A, const bf16_t* Bt, int N, int K, bf16_t* O, int ldc, const float* bias, const bf16_t* Gp, const bf16_t* UZp) {
    pg8::Gemm gm; gm.A = A; gm.Bt = Bt; gm.M = NTOK; gm.N = N; gm.K = K;
    pg8::StaticOrder S; S.init(NTOK, N, (int)gridDim.x, (int)blockIdx.x);
    pg8::EpiM<MODE> E; E.O = O; E.ldc = ldc; E.bias = bias; E.G = Gp; E.UZ = UZp; E.UG = (bf16_t*)(ws_ + OFF_UG); E.qscale = 0.12751743082459868f;
    pg8::gemm_phase<pg8::EpiM<MODE>, pg8::StaticOrder, GEMM_ALIGN, GEMM_SP2>(lds, gm, S, E);
}

#ifndef PHASE_MASK
#define PHASE_MASK 0x7ff
#endif
constexpr int N_PHASES = 11;
__global__ __launch_bounds__(512, 2) void mega_fwd(Params p, int ph_lo, int ph_hi) {
    extern __shared__ __attribute__((aligned(16))) unsigned char shm[];
    LAS unsigned char* lds = (LAS unsigned char*)shm;
    cg::grid_group grid = cg::this_grid();
    unsigned char* ws = p.ws;
    volatile LAS unsigned* xst = (volatile LAS unsigned*)(lds + LDS_BYTES - 16);
    if (threadIdx.x == 0) { xst[0] = 0u; xst[1] = 0u; }
    __syncthreads();
    const XcdBarrier xb = xcd_barrier_post((unsigned*)ws, xst);
    if (ph_lo < 0) grid.sync();
#ifndef REPEAT_MASK
#define REPEAT_MASK 0
#endif
#define PH_BEGIN(k) if (ph_lo <= (k) && (k) < ph_hi) { if ((k) > ph_lo) xcd_barrier(xb); for (int rep_ = 0; rep_ <= ((REPEAT_MASK >> (k)) & 1); ++rep_) {
#define PH_END }}
    PH_BEGIN(0) phase_mod(p, lds); PH_END
    PH_BEGIN(1) phase_rows<0>(p, lds); phase_transposes(p, lds); PH_END
    PH_BEGIN(2) run_gemm<0>(ws, lds, (const bf16_t*)(ws + OFF_HB), (const bf16_t*)(ws + OFF_W1T), 7168, 2048, (bf16_t*)(ws + OFF_PROJ), 7168, nullptr, nullptr, nullptr); PH_END
    PH_BEGIN(3) phase_mixers(p, lds); PH_END
    PH_BEGIN(4) run_gemm<1>(ws, lds, (const bf16_t*)(ws + OFF_MIX), (const bf16_t*)(ws + OFF_W2T), 2048, 2048, (bf16_t*)(ws + OFF_Y0), 2048, nullptr, nullptr, nullptr); PH_END
    PH_BEGIN(5) phase_rows<1>(p, lds); PH_END
    PH_BEGIN(6) run_gemm<2>(ws, lds, (const bf16_t*)(ws + OFF_HB), (const bf16_t*)(ws + OFF_W3T), 2048, 2048, (bf16_t*)(ws + OFF_UZ), 2048, nullptr, nullptr, nullptr); PH_END
    PH_BEGIN(7) for (int it = blockIdx.x; it < 256; it += gridDim.x) ssm_item(p, lds, it >> 6, it & 63); PH_END
    PH_BEGIN(8) run_gemm<3>(ws, lds, (const bf16_t*)(ws + OFF_MIX), (const bf16_t*)(ws + OFF_W4T), 1024, 1024, (bf16_t*)(ws + OFF_MIX) + (size_t)NTOK * 1024, 1024, p.b_glu, (const bf16_t*)(ws + OFF_MIX), (const bf16_t*)(ws + OFF_UZ)); PH_END
    PH_BEGIN(9) run_gemm<1>(ws, lds, (const bf16_t*)(ws + OFF_MIX) + (size_t)NTOK * 1024, (const bf16_t*)(ws + OFF_W5T), 2048, 1024, (bf16_t*)(ws + OFF_Y1), 2048, nullptr, nullptr, nullptr); PH_END
    PH_BEGIN(10) phase_rows<2>(p, lds); PH_END
}

extern "C" void kernel_launch(void* const* d_in, const int* in_sizes, int n_in, void* d_out, int out_size, void* d_ws, size_t ws_size, hipStream_t stream) {
    static int grid = 0;
    if (grid == 0) {
        if (n_in != 23 || out_size != NTOK * DM || ws_size < WS_END) { fprintf(stderr, "kernel_launch: unexpected shapes (n_in %d out %d ws %zu need %zu)\n", n_in, out_size, ws_size, (size_t)WS_END); grid = -1; return; }
        int dev = 0, cus = 0, per_cu = 0;
        (void)hipGetDevice(&dev); (void)hipDeviceGetAttribute(&cus, hipDeviceAttributeMultiprocessorCount, dev);
        if (hipFuncSetAttribute((const void*)mega_fwd, hipFuncAttributeMaxDynamicSharedMemorySize, LDS_BYTES) != hipSuccess) { fprintf(stderr, "kernel_launch: hipFuncSetAttribute failed\n"); grid = -1; return; }
        if (hipOccupancyMaxActiveBlocksPerMultiprocessor(&per_cu, (const void*)mega_fwd, 512, LDS_BYTES) != hipSuccess || per_cu < 1) { fprintf(stderr, "kernel_launch: occupancy query says %d\n", per_cu); per_cu = 1; }
        (void)hipGetLastError();
        grid = cus * 1;
        fprintf(stderr, "kernel_launch: grid %d (cus %d, per_cu %d)\n", grid, cus, per_cu);
    }
    if (grid < 0) return;
    if (hipMemsetAsync((char*)d_ws + OFF_BAR, 0, 16384, stream) != hipSuccess) { fprintf(stderr, "kernel_launch: memset of the barrier words failed\n"); return; }
    Params p{};
    const float** pp = (const float**)&p;
    for (int i = 0; i < 23; ++i) pp[i] = (const float*)d_in[i];
    p.out = (float*)d_out; p.ws = (unsigned char*)d_ws;
#if MULTI_LAUNCH
    for (int ph = 0; ph < N_PHASES; ++ph) {
        hipLaunchKernelGGL(mega_fwd, dim3(grid), dim3(512), LDS_BYTES, stream, p, ph, ph + 1);
    }
#else
    int lo = 0, hi = N_PHASES;
    void* args[] = {(void*)&p, (void*)&lo, (void*)&hi};
    hipError_t e = hipLaunchCooperativeKernel((const void*)mega_fwd, dim3(grid), dim3(512), args, LDS_BYTES, stream);
    if (e != hipSuccess) fprintf(stderr, "cooperative launch failed: %s (grid %d)\n", hipGetErrorString(e), grid);
#endif
}
```

```cpp
#include <hip/hip_runtime.h>
#include <hip/hip_cooperative_groups.h>
#include <cstdio>
#include <cstdint>
namespace cg = cooperative_groups;

#ifndef GEMM_ALIGN
#define GEMM_ALIGN true
#endif
#ifndef GEMM_SP2
#define GEMM_SP2 true
#endif
#ifndef ATT_REP
#define ATT_REP 1
#endif
#ifndef SGU_REP
#define SGU_REP 1
#endif
#ifndef MULTI_LAUNCH
#define MULTI_LAUNCH 0
#endif

namespace pg8 {
#define PG8_LAS __attribute__((address_space(3)))
typedef unsigned short bf16_t;
typedef short bf16x8 __attribute__((ext_vector_type(8)));
typedef float f32x4 __attribute__((ext_vector_type(4)));
typedef unsigned u32x4 __attribute__((ext_vector_type(4)));
constexpr int BM = 256, BK = 64, HALF = 128, HTB = HALF * BK * 2  , STAGE_BYTES = 8 * HTB, NXCD = 8, WGM = 2;

__host__ __device__ __forceinline__ int lds_byte(int r, int c) { const int st = (r >> 4) * 2 + (c >> 5), rr = r & 15, cc = c & 31, ob = rr * 64 + cc * 2; return st * 1024 + (ob ^ (((ob >> 9) & 1) << 5)); }
__host__ __device__ __forceinline__ void stage_rc(int b, int& R, int& C) { const int st = b / 1024, sb = b % 1024, swz = sb ^ (((sb >> 9) & 1) << 5); R = (st >> 1) * 16 + swz / 64; C = (st & 1) * 32 + (swz % 64) / 2; }
__host__ __device__ __forceinline__ int perm32(int rho) { const int n = rho >> 4, i = rho & 15; return 8 * (i >> 2) + 4 * n + (i & 3); }

struct Unit { int pm, pn; };
struct Gemm { const bf16_t* A; const bf16_t* Bt; int M, N, K; };

struct StaticOrder {
    int nM, nN, nwg, G, c;
    __host__ __device__ void init(int M, int N, int G_, int c_) { nM = M / BM; nN = N / BM; nwg = nM * nN; G = G_; c = c_; }
    __host__ __device__ bool next(int i, Unit& u) const {
        const long L = (long)i * G + c; if (L >= nwg) return false;
        int wgid = (int)L; { const int q = nwg / NXCD, r = nwg % NXCD, xcd = wgid % NXCD, off = wgid / NXCD; wgid = (xcd < r ? xcd * (q + 1) : r * (q + 1) + (xcd - r) * q) + off; }
        const int nig = WGM * nN, gid = wgid / nig, fm = gid * WGM, gsz = (nM - fm) < WGM ? (nM - fm) : WGM;
        u.pm = fm + ((wgid % nig) % gsz); u.pn = (wgid % nig) / gsz; return true;
    }
    __device__ __forceinline__ void a_ready(const Unit&) const {}
    __device__ __forceinline__ void done(const Unit&) const {}
};


__device__ __forceinline__ unsigned cvt_pk_bf16(float lo, float hi) { unsigned r; asm volatile("v_cvt_pk_bf16_f32 %0, %1, %2" : "=v"(r) : "v"(lo), "v"(hi)); return r; }

template <class Epi, class Sched, bool ALIGN_EPI = false, bool SP2 = false>
__device__ __forceinline__ void gemm_phase(PG8_LAS unsigned char* lds, const Gemm g, const Sched& S, const Epi& E) {
    const int tid = threadIdx.x, wid = __builtin_amdgcn_readfirstlane(tid >> 6), lane = tid & 63, wr = wid >> 2, wc = wid & 3, fr = lane & 15, fq = lane >> 4;
    const int K = g.K, nt = K / BK;
    unsigned voffA[2], voffB[2];
#pragma unroll
    for (int i = 0; i < 2; ++i) { int R, C; stage_rc(tid * 16 + i * 8192, R, C); const int Rb = Epi::PERM ? ((R & ~31) + perm32(R & 31)) : R;
        voffA[i] = (unsigned)(R * K + C) * 2u; voffB[i] = (unsigned)(Rb * K + C) * 2u; }
    const size_t kstep = (size_t)(BK * 2);
    const size_t hstep = (size_t)HALF * K * 2;
    const size_t tstep = 2 * hstep;
    const unsigned ldsw = (unsigned)wid * 1024u;
    const int aoff = lds_byte(wr * 64 + fr, fq * 8), boff = lds_byte(wc * 32 + fr, fq * 8);
#define PG8_SA(b, h) (((b) * 2 + (h)) * HTB)
#define PG8_SB(b, h) ((4 + (b) * 2 + (h)) * HTB)
#define PG8_STAGE(bufoff, gbase, voff) do { _Pragma("unroll") for (int _i = 0; _i < 2; ++_i) \
        __builtin_amdgcn_global_load_lds((const unsigned*)((const char*)(gbase) + (voff)[_i]), (PG8_LAS unsigned*)(lds + (bufoff) + ldsw + _i * 8192), 16, 0, 0); } while (0)
#define PG8_LDA(dst, b, h) do { _Pragma("unroll") for (int m = 0; m < 4; ++m) _Pragma("unroll") for (int k = 0; k < 2; ++k) dst[m][k] = *(const PG8_LAS bf16x8*)(lds + PG8_SA(b, h) + aoff + m * 2048 + k * 1024); } while (0)
#define PG8_LDB(dst, b, h) do { _Pragma("unroll") for (int n = 0; n < 2; ++n) _Pragma("unroll") for (int k = 0; k < 2; ++k) dst[n][k] = *(const PG8_LAS bf16x8*)(lds + PG8_SB(b, h) + boff + n * 2048 + k * 1024); } while (0)
#define PG8_MMA(ai, bj, At, Bt) do { __builtin_amdgcn_s_setprio(1); _Pragma("unroll") for (int m = 0; m < 4; ++m) _Pragma("unroll") for (int n = 0; n < 2; ++n) _Pragma("unroll") for (int k = 0; k < 2; ++k) \
        acc[ai][bj][m][n] = __builtin_amdgcn_mfma_f32_16x16x32_bf16(Bt[n][k], At[m][k], acc[ai][bj][m][n], 0, 0, 0); __builtin_amdgcn_s_setprio(0); } while (0)
#define PG8_WAIT_V(n) asm volatile("s_waitcnt vmcnt(" #n ")" ::: "memory")
#define PG8_WAIT_L(n) asm volatile("s_waitcnt lgkmcnt(" #n ")" ::: "memory")
#define PG8_BAR __builtin_amdgcn_s_barrier()
#define PG8_SCHED __builtin_amdgcn_sched_barrier(0)
    Unit cur, nxt; int ui = 0;
    if (!S.next(0, cur)) return;
    f32x4 acc[2][2][4][2];
#pragma unroll
    for (int a = 0; a < 2; ++a)
#pragma unroll
        for (int b = 0; b < 2; ++b)
#pragma unroll
            for (int m = 0; m < 4; ++m)
#pragma unroll
                for (int n = 0; n < 2; ++n) acc[a][b][m][n] = (f32x4){0.f, 0.f, 0.f, 0.f};
    bf16x8 At[4][2], B0[2][2], B1[2][2];
    const char* cA = (const char*)g.A + (size_t)cur.pm * tstep; const char* cB = (const char*)g.Bt + (size_t)cur.pn * tstep;
    S.a_ready(cur);
    if constexpr (SP2) {
        PG8_STAGE(PG8_SB(0, 0), cB, voffB); PG8_STAGE(PG8_SB(0, 1), cB + hstep, voffB); PG8_STAGE(PG8_SA(0, 0), cA, voffA); PG8_STAGE(PG8_SA(0, 1), cA + hstep, voffA);
        if (wr == 1) PG8_BAR;
        PG8_WAIT_V(2); PG8_BAR;
        PG8_STAGE(PG8_SB(1, 0), cB + kstep, voffB); PG8_STAGE(PG8_SA(1, 0), cA + kstep, voffA); PG8_STAGE(PG8_SB(1, 1), cB + hstep + kstep, voffB);
        PG8_WAIT_V(6); PG8_BAR;
    } else {
        PG8_STAGE(PG8_SB(0, 0), cB, voffB); PG8_STAGE(PG8_SA(0, 0), cA, voffA); PG8_STAGE(PG8_SB(0, 1), cB + hstep, voffB); PG8_STAGE(PG8_SA(0, 1), cA + hstep, voffA);
        if (wr == 1) PG8_BAR;
        PG8_WAIT_V(4); PG8_BAR;
        PG8_STAGE(PG8_SB(1, 0), cB + kstep, voffB); PG8_STAGE(PG8_SA(1, 0), cA + kstep, voffA); PG8_STAGE(PG8_SB(1, 1), cB + hstep + kstep, voffB);
        PG8_WAIT_V(6); PG8_BAR;
    }
    for (;;) {
        const bool has_next = S.next(ui + 1, nxt);
        const char* nA = has_next ? (const char*)g.A + (size_t)nxt.pm * tstep : cA; const char* nB = has_next ? (const char*)g.Bt + (size_t)nxt.pn * tstep : cB;
        for (int t = 0; t < nt; t += 2) {
            const bool last = (t == nt - 2);
            const char* a1 = cA + (size_t)(t + 1) * kstep;
            const char* a2 = last ? nA : cA + (size_t)(t + 2) * kstep; const char* b2 = last ? nB : cB + (size_t)(t + 2) * kstep;
            const char* a3 = a2 + kstep; const char* b3 = b2 + kstep;
            if (last && has_next) S.a_ready(nxt);
            if constexpr (SP2) {
            PG8_LDB(B0, 0, 0); PG8_LDB(B1, 0, 1); PG8_SCHED; PG8_LDA(At, 0, 0); PG8_STAGE(PG8_SA(1, 1), a1 + hstep, voffA);
            PG8_WAIT_V(8); PG8_WAIT_L(0); PG8_BAR; PG8_MMA(0, 0, At, B0); PG8_MMA(0, 1, At, B1); PG8_BAR; PG8_SCHED;
            PG8_LDA(At, 0, 1); PG8_STAGE(PG8_SB(0, 0), b2, voffB); PG8_STAGE(PG8_SB(0, 1), b2 + hstep, voffB); PG8_STAGE(PG8_SA(0, 0), a2, voffA);
            PG8_WAIT_V(8); PG8_WAIT_L(0); PG8_BAR; PG8_MMA(1, 0, At, B0); PG8_MMA(1, 1, At, B1); PG8_BAR; PG8_SCHED;
            PG8_LDB(B0, 1, 0); PG8_LDB(B1, 1, 1); PG8_SCHED; PG8_LDA(At, 1, 0); PG8_STAGE(PG8_SA(0, 1), a2 + hstep, voffA);
            PG8_WAIT_V(8); PG8_WAIT_L(0); PG8_BAR; PG8_MMA(0, 0, At, B0); PG8_MMA(0, 1, At, B1); PG8_BAR; PG8_SCHED;
            PG8_LDA(At, 1, 1); PG8_STAGE(PG8_SB(1, 0), b3, voffB); PG8_STAGE(PG8_SB(1, 1), b3 + hstep, voffB); PG8_STAGE(PG8_SA(1, 0), a3, voffA);
            PG8_WAIT_V(8); PG8_WAIT_L(0); PG8_BAR; PG8_MMA(1, 0, At, B0); PG8_MMA(1, 1, At, B1); PG8_BAR; PG8_SCHED;
            } else {
            PG8_LDB(B0, 0, 0); PG8_SCHED; PG8_LDA(At, 0, 0); PG8_STAGE(PG8_SA(1, 1), a1 + hstep, voffA);
            PG8_WAIT_L(8); PG8_BAR; PG8_WAIT_L(0); PG8_MMA(0, 0, At, B0); PG8_BAR; PG8_SCHED;
            PG8_LDB(B1, 0, 1); PG8_STAGE(PG8_SB(0, 0), b2, voffB);
            PG8_BAR; PG8_WAIT_L(0); PG8_MMA(0, 1, At, B1); PG8_BAR;
            PG8_LDA(At, 0, 1); PG8_STAGE(PG8_SA(0, 0), a2, voffA);
            PG8_BAR; PG8_WAIT_L(0); PG8_MMA(1, 0, At, B0); PG8_BAR; PG8_SCHED;
            PG8_STAGE(PG8_SB(0, 1), b2 + hstep, voffB);
            PG8_WAIT_V(6); PG8_BAR; PG8_MMA(1, 1, At, B1); PG8_BAR;
            PG8_LDB(B0, 1, 0); PG8_SCHED; PG8_LDA(At, 1, 0); PG8_STAGE(PG8_SA(0, 1), a2 + hstep, voffA);
            PG8_WAIT_L(8); PG8_BAR; PG8_WAIT_L(0); PG8_MMA(0, 0, At, B0); PG8_BAR; PG8_SCHED;
            PG8_LDB(B1, 1, 1); PG8_STAGE(PG8_SB(1, 0), b3, voffB);
            PG8_BAR; PG8_WAIT_L(0); PG8_MMA(0, 1, At, B1); PG8_BAR;
            PG8_LDA(At, 1, 1); PG8_STAGE(PG8_SA(1, 0), a3, voffA);
            PG8_BAR; PG8_WAIT_L(0); PG8_MMA(1, 0, At, B0); PG8_BAR; PG8_SCHED;
            PG8_STAGE(PG8_SB(1, 1), b3 + hstep, voffB);
            PG8_WAIT_V(6); PG8_BAR; PG8_MMA(1, 1, At, B1); PG8_BAR;
            }
        }
        if constexpr (ALIGN_EPI) { if (wr == 0) PG8_BAR; }
        if constexpr (!Epi::AFTER_DRAIN) { E(acc, cur, wr, wc, fr, fq); S.done(cur); }
        if (!has_next) break;
#pragma unroll
        for (int a = 0; a < 2; ++a)
#pragma unroll
            for (int b = 0; b < 2; ++b)
#pragma unroll
                for (int m = 0; m < 4; ++m)
#pragma unroll
                    for (int n = 0; n < 2; ++n) acc[a][b][m][n] = (f32x4){0.f, 0.f, 0.f, 0.f};
        cur = nxt; cA = nA; cB = nB; ++ui;
        if constexpr (ALIGN_EPI) { if (wr == 1) PG8_BAR; }
    }
    PG8_WAIT_V(0);
    if constexpr (!ALIGN_EPI) { if (wr == 0) PG8_BAR; }
    PG8_BAR;
    if constexpr (Epi::AFTER_DRAIN) { E.fused(acc, cur, wr, wc, fr, fq, lds, wid, lane); S.done(cur); }
#undef PG8_SA
#undef PG8_SB
#undef PG8_STAGE
#undef PG8_LDA
#undef PG8_LDB
#undef PG8_MMA
#undef PG8_WAIT_V
#undef PG8_WAIT_L
#undef PG8_BAR
#undef PG8_SCHED
}

__device__ __forceinline__ float bf2f(unsigned short b) { return __uint_as_float(((unsigned)b) << 16); }
__device__ __forceinline__ unsigned short f2bf(float f) { unsigned u = __float_as_uint(f); u += 0x7FFFu + ((u >> 16) & 1u); return (unsigned short)(u >> 16); }
__device__ __forceinline__ float sigmoid_f(float x) { return __builtin_amdgcn_rcpf(1.f + __expf(-x)); }
__device__ __forceinline__ float silu_f(float x) { return x * sigmoid_f(x); }
__device__ __forceinline__ float gelu_f(float x) { const float u = 0.7978845608028654f * (x + 0.044715f * x * x * x); return x * sigmoid_f(2.f * u); }

template <int MODE> struct EpiM {
    static constexpr bool PERM = true, AFTER_DRAIN = false;
    bf16_t* O; int ldc; const float* bias; const bf16_t* G; const bf16_t* UZ; float qscale; bf16_t* UG;
    __device__ __forceinline__ void operator()(const f32x4 (&acc)[2][2][4][2], const Unit& u, int wr, int wc, int fr, int fq) const {
        const int row0 = u.pm * BM + wr * 64 + fr; const int colt = u.pn * BM; const int col0 = colt + wc * 32 + 8 * fq;
        int act = 0;
        if (MODE == 0) { const int seg = colt >> 10; act = (seg <= 1) ? 1 : ((seg == 2 || seg == 6) ? 2 : (seg == 3 ? 3 : 0)); }
        if (MODE == 2) { act = (colt >= 1024) ? 2 : 0; }
#pragma unroll
        for (int ai = 0; ai < 2; ++ai)
#pragma unroll
            for (int m = 0; m < 4; ++m) {
                const int row = row0 + ai * HALF + m * 16;
#pragma unroll
                for (int bj = 0; bj < 2; ++bj) {
                    const int col = col0 + bj * HALF;
                    float v[8];
#pragma unroll
                    for (int j = 0; j < 4; ++j) { v[j] = acc[ai][bj][m][0][j]; v[4 + j] = acc[ai][bj][m][1][j]; }
                    if (MODE == 0 || MODE == 2) {
                        if (act == 1) {
#pragma unroll
                            for (int j = 0; j < 8; ++j) v[j] = gelu_f(v[j]);
                        } else if (act == 2) {
#pragma unroll
                            for (int j = 0; j < 8; ++j) v[j] = silu_f(v[j]);
                        } else if (act == 3) {
#pragma unroll
                            for (int j = 0; j < 8; ++j) v[j] = v[j] * qscale;
                        }
                    }
                    if (MODE == 3) {
                        const f32x4 b0 = *(const f32x4*)(bias + col), b1 = *(const f32x4*)(bias + col + 4);
                        const bf16x8 gv = *(const bf16x8*)(G + (size_t)row * 1024 + col);
                        const bf16x8 zv = *(const bf16x8*)(UZ + (size_t)row * 2048 + 1024 + col);
#pragma unroll
                        for (int j = 0; j < 8; ++j) { const float t = v[j] + (j < 4 ? b0[j & 3] : b1[j & 3]); v[j] = bf2f((unsigned short)gv[j]) * sigmoid_f(t) * bf2f((unsigned short)zv[j]); }
                    }
                    u32x4 w; w.x = cvt_pk_bf16(v[0], v[1]); w.y = cvt_pk_bf16(v[2], v[3]); w.z = cvt_pk_bf16(v[4], v[5]); w.w = cvt_pk_bf16(v[6], v[7]);
                    if (MODE == 2 && colt < 1024) *(u32x4*)(UG + ((size_t)((row >> 12) * 64 + (col >> 4)) * 4096 + (row & 4095)) * 16 + (col & 15)) = w;
                    else *(u32x4*)(O + (size_t)row * ldc + col) = w;
                }
            }
    }
};
}

using pg8::bf16_t; using pg8::bf16x8; using pg8::f32x4; using pg8::u32x4; using pg8::bf2f; using pg8::f2bf; using pg8::silu_f; using pg8::gelu_f; using pg8::sigmoid_f; using pg8::cvt_pk_bf16;
#define LAS __attribute__((address_space(3)))
typedef unsigned u32x2 __attribute__((ext_vector_type(2)));
typedef float f32x2v __attribute__((ext_vector_type(2)));

constexpr int NTOK = 16384, DM = 2048, SEQ = 4096;
constexpr float EPS = 1e-6f;
constexpr int LDS_BYTES = 148480;
constexpr size_t OFF_BAR = 0;
constexpr size_t OFF_MODP = 16384;
constexpr size_t OFF_W1T = OFF_MODP + (size_t)8 * 2 * 4 * 6144 * 4;
constexpr size_t OFF_W2T = OFF_W1T + (size_t)7168 * 2048 * 2;
constexpr size_t OFF_W3T = OFF_W2T + (size_t)2048 * 2048 * 2;
constexpr size_t OFF_W4T = OFF_W3T + (size_t)2048 * 2048 * 2;
constexpr size_t OFF_W5T = OFF_W4T + (size_t)1024 * 1024 * 2;
constexpr size_t OFF_HB = OFF_W5T + (size_t)2048 * 1024 * 2;
constexpr size_t OFF_MIX = OFF_HB + (size_t)NTOK * 2048 * 2;
constexpr size_t OFF_PROJ = OFF_MIX + (size_t)NTOK * 2048 * 2;
constexpr size_t OFF_Y0 = OFF_PROJ;
constexpr size_t OFF_UZ = OFF_Y0 + (size_t)NTOK * 2048 * 2;
constexpr size_t OFF_Y1 = OFF_UZ + (size_t)NTOK * 2048 * 2;
constexpr size_t OFF_UG = OFF_Y1 + (size_t)NTOK * 2048 * 2;
constexpr size_t WS_END = OFF_PROJ + (size_t)NTOK * 7168 * 2;
static_assert(OFF_UG + (size_t)NTOK * 1024 * 2 <= WS_END, "workspace map");

struct Params {
    const float *x, *c, *ln_pre_g, *ln_post_g, *w_mod, *b_mod, *w_in_ab, *w_out_ab, *sgu_norm_g, *sgu_w, *sgu_b,
        *w_in_ssm, *w_out_ssm, *lam_re, *lam_im, *b_re, *b_im, *c_re, *c_im, *d_skip, *log_dt, *w_glu, *b_glu;
    float* out; unsigned char* ws;
};

__device__ __forceinline__ float wave_sum(float v) {
#pragma unroll
    for (int o = 1; o < 64; o <<= 1) v += __shfl_xor(v, o);
    return v;
}
__device__ __forceinline__ void wave_lds_sync() { asm volatile("s_waitcnt lgkmcnt(0)" ::: "memory"); }
typedef short s16x4 __attribute__((ext_vector_type(4)));
__device__ __forceinline__ s16x4 lds_tr16(const LAS bf16_t* p) { return __builtin_amdgcn_ds_read_tr16_b64_v4i16((LAS s16x4*)p); }
__device__ __forceinline__ bf16x8 cat4(s16x4 lo, s16x4 hi) { return __builtin_shufflevector(lo, hi, 0, 1, 2, 3, 4, 5, 6, 7); }
__device__ __forceinline__ f32x4 mfma16(bf16x8 a, bf16x8 b, f32x4 c) { return __builtin_amdgcn_mfma_f32_16x16x32_bf16(a, b, c, 0, 0, 0); }

__device__ __forceinline__ void phase_mod(const Params& p, LAS unsigned char* lds) {
    LAS float* sc = (LAS float*)lds;
    LAS float* part = sc + 8192;
    const int tid = threadIdx.x;
    for (int i = tid; i < 8192; i += 512) sc[i] = silu_f(p.c[i]);
    __syncthreads();
    float* MOD = (float*)(p.ws + OFF_MODP);
    for (int cb = blockIdx.x; cb < 256; cb += gridDim.x) {
        const int l = cb >> 7, col0 = (cb & 127) * 48, q = tid % 12, kg = tid / 12;
        if (kg < 42) {
            f32x4 acc[4];
#pragma unroll
            for (int b = 0; b < 4; ++b) acc[b] = (f32x4){0.f, 0.f, 0.f, 0.f};
            const float* W = p.w_mod + (size_t)l * 2048 * 6144 + col0 + 4 * q;
#pragma unroll 8
            for (int k = kg; k < 2048; k += 42) { const f32x4 w = __builtin_nontemporal_load((const f32x4*)(W + (size_t)k * 6144));
#pragma unroll
                for (int b = 0; b < 4; ++b) { const float sv = sc[b * 2048 + k]; acc[b] += w * sv; } }
#pragma unroll
            for (int b = 0; b < 4; ++b) *(LAS f32x4*)(part + (kg * 4 + b) * 48 + 4 * q) = acc[b];
        }
        __syncthreads();
        if (tid < 192) { const int b = tid / 48, c = tid % 48; float sm = p.b_mod[l * 6144 + col0 + c];
            for (int g2 = 0; g2 < 42; ++g2) sm += part[(g2 * 4 + b) * 48 + c];
            MOD[((size_t)l * 4 + b) * 6144 + col0 + c] = sm; }
        __syncthreads();
    }
}
__device__ __forceinline__ void transpose_item(const float* W, int K, int N, bf16_t* WT, LAS float* scr, int item, int lane) {
    const int nblk = N / 32, kb = item / nblk, nb = item % nblk, k0 = 64 * kb, n0 = 32 * nb;
#pragma unroll
    for (int i = 0; i < 32; ++i) { const int kk = 2 * i + (lane >> 5); scr[kk * 33 + (lane & 31)] = __builtin_nontemporal_load(W + (size_t)(k0 + kk) * N + n0 + (lane & 31)); }
    wave_lds_sync();
    const int c = lane & 7;
#pragma unroll
    for (int j = 0; j < 4; ++j) { const int n = (lane >> 3) + 8 * j; const LAS float* sp = scr + (8 * c) * 33 + n;
        u32x4 o; o.x = cvt_pk_bf16(sp[0 * 33], sp[1 * 33]); o.y = cvt_pk_bf16(sp[2 * 33], sp[3 * 33]); o.z = cvt_pk_bf16(sp[4 * 33], sp[5 * 33]); o.w = cvt_pk_bf16(sp[6 * 33], sp[7 * 33]);
        *(u32x4*)(WT + (size_t)(n0 + n) * K + k0 + 8 * c) = o; }
    wave_lds_sync();
}
__device__ __forceinline__ void phase_transposes(const Params& p, LAS unsigned char* lds) {
    const int tid = threadIdx.x, wid = __builtin_amdgcn_readfirstlane(tid >> 6), lane = tid & 63;
    LAS float* scr = (LAS float*)(lds + 32768 + wid * 8448);
    constexpr int I1 = 32 * 224, I2 = 32 * 64, I3 = 32 * 64, I4 = 16 * 32, I5 = 16 * 64, NITEMS = I1 + I2 + I3 + I4 + I5;
    const int gw = blockIdx.x * 8 + wid, NW = gridDim.x * 8;
    for (int it = gw; it < NITEMS; it += NW) {
        int r = it;
        if (r < I1) { transpose_item(p.w_in_ab, 2048, 7168, (bf16_t*)(p.ws + OFF_W1T), scr, r, lane); continue; } r -= I1;
        if (r < I2) { transpose_item(p.w_out_ab, 2048, 2048, (bf16_t*)(p.ws + OFF_W2T), scr, r, lane); continue; } r -= I2;
        if (r < I3) { transpose_item(p.w_in_ssm, 2048, 2048, (bf16_t*)(p.ws + OFF_W3T), scr, r, lane); continue; } r -= I3;
        if (r < I4) { transpose_item(p.w_glu, 1024, 1024, (bf16_t*)(p.ws + OFF_W4T), scr, r, lane); continue; } r -= I4;
        transpose_item(p.w_out_ssm, 1024, 2048, (bf16_t*)(p.ws + OFF_W5T), scr, r, lane);
    }
}

__device__ __forceinline__ float mod_val(const Params& p, int l, int b, int j) { return ((const float*)(p.ws + OFF_MODP))[((size_t)l * 4 + b) * 6144 + j]; }
template <int WHICH> __device__ __forceinline__ void phase_rows(const Params& p, LAS unsigned char* lds) {
    LAS float* vA = (LAS float*)lds;
    LAS float* vB = vA + 2048;
    LAS float* vG = vB + 2048;
    LAS float* vH = vG + 2048;
    const int tid = threadIdx.x, wid = __builtin_amdgcn_readfirstlane(tid >> 6), lane = tid & 63;
    bf16_t* HB = (bf16_t*)(p.ws + OFF_HB);
    for (int chunk = blockIdx.x; chunk < NTOK / 64; chunk += gridDim.x) {
        const int row0 = chunk * 64, b = row0 >> 12;
        __syncthreads();
        for (int j = tid; j < 2048; j += 512) {
            if (WHICH == 0) { vA[j] = p.ln_pre_g[j] * (1.f + mod_val(p, 0, b, 2048 + j)); vB[j] = mod_val(p, 0, b, j); }
            if (WHICH == 1) { vG[j] = mod_val(p, 0, b, 4096 + j) * p.ln_post_g[j]; vA[j] = p.ln_pre_g[2048 + j] * (1.f + mod_val(p, 1, b, 2048 + j)); vB[j] = mod_val(p, 1, b, j); }
            if (WHICH == 2) { vG[j] = mod_val(p, 0, b, 4096 + j) * p.ln_post_g[j]; vH[j] = mod_val(p, 1, b, 4096 + j) * p.ln_post_g[2048 + j]; }
        }
        __syncthreads();
        for (int r = wid; r < 64; r += 8) {
            const size_t row = (size_t)(row0 + r);
            f32x4 xv[8];
#pragma unroll
            for (int j = 0; j < 8; ++j) xv[j] = (WHICH == 0) ? __builtin_nontemporal_load((const f32x4*)(p.x + row * 2048 + (lane + 64 * j) * 4)) : *(const f32x4*)(p.x + row * 2048 + (lane + 64 * j) * 4);
#pragma unroll
            for (int pass = 0; pass < 2; ++pass) {
                if (WHICH == 0 || (WHICH == 1 && pass == 1)) continue;
                const bf16_t* Y = (const bf16_t*)(p.ws + (pass == 0 ? OFF_Y0 : OFF_Y1));
                LAS float* gvec = (pass == 0) ? vG : vH;
                f32x4 yv[8]; float ssy = 0.f;
#pragma unroll
                for (int j = 0; j < 8; ++j) { const u32x2 w = *(const u32x2*)(Y + row * 2048 + (lane + 64 * j) * 4);
                    yv[j][0] = __uint_as_float(w.x << 16); yv[j][1] = __uint_as_float(w.x & 0xffff0000u); yv[j][2] = __uint_as_float(w.y << 16); yv[j][3] = __uint_as_float(w.y & 0xffff0000u);
                    ssy += yv[j][0] * yv[j][0] + yv[j][1] * yv[j][1] + yv[j][2] * yv[j][2] + yv[j][3] * yv[j][3]; }
                const float ry = rsqrtf(wave_sum(ssy) * (1.f / 2048.f) + EPS);
#pragma unroll
                for (int j = 0; j < 8; ++j) { const f32x4 gv = *(const LAS f32x4*)(gvec + (lane + 64 * j) * 4);
#pragma unroll
                    for (int e = 0; e < 4; ++e) xv[j][e] += gv[e] * (yv[j][e] * ry); }
            }
            if (WHICH == 2) {
#pragma unroll
                for (int j = 0; j < 8; ++j) *(f32x4*)(p.out + row * 2048 + (lane + 64 * j) * 4) = xv[j];
            } else {
                float ss = 0.f;
#pragma unroll
                for (int j = 0; j < 8; ++j) ss += xv[j][0] * xv[j][0] + xv[j][1] * xv[j][1] + xv[j][2] * xv[j][2] + xv[j][3] * xv[j][3];
                const float rx = rsqrtf(wave_sum(ss) * (1.f / 2048.f) + EPS);
#pragma unroll
                for (int j = 0; j < 8; ++j) { const f32x4 av = *(const LAS f32x4*)(vA + (lane + 64 * j) * 4), bv = *(const LAS f32x4*)(vB + (lane + 64 * j) * 4);
                    u32x2 w; w.x = cvt_pk_bf16(xv[j][0] * rx * av[0] + bv[0], xv[j][1] * rx * av[1] + bv[1]); w.y = cvt_pk_bf16(xv[j][2] * rx * av[2] + bv[2], xv[j][3] * rx * av[3] + bv[3]);
                    *(u32x2*)(HB + row * 2048 + (lane + 64 * j) * 4) = w; }
            }
        }
    }
}

__device__ __forceinline__ void sgu_item(const Params& p, LAS unsigned char* lds, int b, int n, int h) {
    LAS bf16_t* Ws = (LAS bf16_t*)lds;
    LAS bf16_t* Vn = Ws + 128 * 136;
    const int tid = threadIdx.x, wid = __builtin_amdgcn_readfirstlane(tid >> 6), lane = tid & 63, fr = lane & 15, g = lane >> 4;
    const bf16_t* P = (const bf16_t*)(p.ws + OFF_PROJ);
    bf16_t* MIX = (bf16_t*)(p.ws + OFF_MIX);
    const size_t tok0 = (size_t)b * SEQ + (size_t)n * 128;
    __syncthreads();
    const float* Wg = p.sgu_w + (size_t)h * 16384;
#pragma unroll
    for (int i = 0; i < 8; ++i) { const int idx = tid + 512 * i, r = idx >> 5, c4 = (idx & 31) * 4;
        f32x4 w = *(const f32x4*)(Wg + r * 128 + c4);
        w[0] = (c4 + 0 <= r) ? w[0] : 0.f; w[1] = (c4 + 1 <= r) ? w[1] : 0.f; w[2] = (c4 + 2 <= r) ? w[2] : 0.f; w[3] = (c4 + 3 <= r) ? w[3] : 0.f;
        u32x2 o; o.x = cvt_pk_bf16(w[0], w[1]); o.y = cvt_pk_bf16(w[2], w[3]);
        *(LAS u32x2*)(Ws + r * 136 + c4) = o; }
    {
        const int s = tid >> 2, q4 = tid & 3;
        const bf16_t* src = P + (tok0 + s) * 7168 + 1024 + h * 128 + q4 * 32;
        bf16x8 v[4]; float ss = 0.f;
#pragma unroll
        for (int i = 0; i < 4; ++i) { v[i] = *(const bf16x8*)(src + 8 * i);
#pragma unroll
            for (int j = 0; j < 8; ++j) { const float f = bf2f((unsigned short)v[i][j]); ss += f * f; } }
        ss += __shfl_xor(ss, 1); ss += __shfl_xor(ss, 2);
        const float rn = rsqrtf(ss * (1.f / 128.f) + EPS);
#pragma unroll
        for (int i = 0; i < 4; ++i) { const int d0 = q4 * 32 + 8 * i; const f32x4 g0 = *(const f32x4*)(p.sgu_norm_g + h * 128 + d0), g1 = *(const f32x4*)(p.sgu_norm_g + h * 128 + d0 + 4);
            u32x4 o; o.x = cvt_pk_bf16(bf2f((unsigned short)v[i][0]) * rn * g0[0], bf2f((unsigned short)v[i][1]) * rn * g0[1]); o.y = cvt_pk_bf16(bf2f((unsigned short)v[i][2]) * rn * g0[2], bf2f((unsigned short)v[i][3]) * rn * g0[3]);
            o.z = cvt_pk_bf16(bf2f((unsigned short)v[i][4]) * rn * g1[0], bf2f((unsigned short)v[i][5]) * rn * g1[1]); o.w = cvt_pk_bf16(bf2f((unsigned short)v[i][6]) * rn * g1[2], bf2f((unsigned short)v[i][7]) * rn * g1[3]);
            *(LAS u32x4*)(Vn + s * 144 + d0) = o; }
    }
    const int t = 16 * wid + fr; const size_t tok = tok0 + t; const float bs = p.sgu_b[h * 128 + t];
    u32x2 gur[8], szr[8];
#pragma unroll
    for (int db = 0; db < 8; ++db) { const int col = h * 128 + 16 * db + 4 * g; gur[db] = *(const u32x2*)(P + tok * 7168 + col); szr[db] = *(const u32x2*)(P + tok * 7168 + 2048 + col); }
    __syncthreads();
    const int nks = (wid >> 1) + 1;
    f32x4 acc[8];
#pragma unroll
    for (int db = 0; db < 8; ++db) acc[db] = (f32x4){0.f, 0.f, 0.f, 0.f};
#pragma unroll
    for (int ks = 0; ks < 4; ++ks) {
        if (ks < nks) {
            const LAS bf16_t* wp = Ws + (16 * wid + fr) * 136 + 32 * ks + 4 * g;
            const u32x2 wlo = *(const LAS u32x2*)wp, whi = *(const LAS u32x2*)(wp + 16);
            u32x4 wv; wv.x = wlo.x; wv.y = wlo.y; wv.z = whi.x; wv.w = whi.y;
            const bf16x8 bfrag = __builtin_bit_cast(bf16x8, wv);
#pragma unroll
            for (int db = 0; db < 8; ++db) { const LAS bf16_t* vb = Vn + (32 * ks + 4 * g + (fr >> 2)) * 144 + 16 * db + 4 * (fr & 3);
                acc[db] = mfma16(cat4(lds_tr16(vb), lds_tr16(vb + 16 * 144)), bfrag, acc[db]); }
        }
    }
#pragma unroll
    for (int db = 0; db < 8; ++db) { const int col = h * 128 + 16 * db + 4 * g;
        const u32x2 gu = gur[db], sz = szr[db];
        const float o0 = __uint_as_float(gu.x << 16) * (acc[db][0] + bs) * __uint_as_float(sz.x << 16);
        const float o1 = __uint_as_float(gu.x & 0xffff0000u) * (acc[db][1] + bs) * __uint_as_float(sz.x & 0xffff0000u);
        const float o2 = __uint_as_float(gu.y << 16) * (acc[db][2] + bs) * __uint_as_float(sz.y << 16);
        const float o3 = __uint_as_float(gu.y & 0xffff0000u) * (acc[db][3] + bs) * __uint_as_float(sz.y & 0xffff0000u);
        u32x2 w; w.x = cvt_pk_bf16(o0, o1); w.y = cvt_pk_bf16(o2, o3);
        *(u32x2*)(MIX + tok * 2048 + col) = w; }
}

__device__ __forceinline__ void attn_wave_item(const Params& p, LAS unsigned char* wl, int b, int h, int qblk) {
    LAS bf16_t* Kw = (LAS bf16_t*)wl;
    LAS bf16_t* Vw = Kw + 32 * 144;
    const int lane = threadIdx.x & 63, fr = lane & 15, g = lane >> 4;
    const bf16_t* P = (const bf16_t*)(p.ws + OFF_PROJ);
    bf16_t* MIX = (bf16_t*)(p.ws + OFF_MIX);
    const size_t tokb = (size_t)b * SEQ;
    const int qrow0 = qblk * 32 + fr;
    bf16x8 qf[2][4];
#pragma unroll
    for (int c = 0; c < 2; ++c) { const bf16_t* qp = P + (tokb + qrow0 + 16 * c) * 7168 + 3072 + h * 128 + 8 * g;
#pragma unroll
      for (int ks = 0; ks < 4; ++ks) qf[c][ks] = *(const bf16x8*)(qp + 32 * ks); }
    f32x4 oacc[2][8];
#pragma unroll
    for (int c = 0; c < 2; ++c)
#pragma unroll
        for (int db = 0; db < 8; ++db) oacc[c][db] = (f32x4){0.f, 0.f, 0.f, 0.f};
    float carry0 = 1.f, carry1 = 1.f;
    const int lrow = lane >> 4, ld8 = (lane & 15) * 8;
    bf16x8 kreg[8], vreg[8];
#define AW_LOAD(kt_) do { const bf16_t* base_ = P + (tokb + (size_t)(kt_) * 32 + lrow) * 7168 + h * 128 + ld8; \
        _Pragma("unroll") for (int i_ = 0; i_ < 8; ++i_) { kreg[i_] = *(const bf16x8*)(base_ + (size_t)(4 * i_) * 7168 + 4096); vreg[i_] = *(const bf16x8*)(base_ + (size_t)(4 * i_) * 7168 + 5120); } } while (0)
    AW_LOAD(qblk);
    for (int kt = qblk; kt >= 0; --kt) {
#pragma unroll
        for (int i = 0; i < 8; ++i) { *(LAS bf16x8*)(Kw + (lrow + 4 * i) * 144 + ld8) = kreg[i]; *(LAS bf16x8*)(Vw + (lrow + 4 * i) * 144 + ld8) = vreg[i]; }
        if (kt > 0) AW_LOAD(kt - 1);
        wave_lds_sync();
        bf16x8 pf[2];
#pragma unroll
        for (int c = 0; c < 2; ++c) { const int qrow = qrow0 + 16 * c; float cy = c ? carry1 : carry0;
            f32x4 s0 = (f32x4){0.f, 0.f, 0.f, 0.f}, s1 = (f32x4){0.f, 0.f, 0.f, 0.f};
#pragma unroll
            for (int ks = 0; ks < 4; ++ks) { s0 = mfma16(*(const LAS bf16x8*)(Kw + fr * 144 + 8 * g + 32 * ks), qf[c][ks], s0); s1 = mfma16(*(const LAS bf16x8*)(Kw + (16 + fr) * 144 + 8 * g + 32 * ks), qf[c][ks], s1); }
            float w[2][4];
#pragma unroll
            for (int kk = 0; kk < 2; ++kk) { const int kb = 1 - kk; const f32x4 sv = kb ? s1 : s0;
                float be[4], kp[4];
#pragma unroll
                for (int r = 0; r < 4; ++r) { const float z = sv[r]; const int kpos = kt * 32 + 16 * kb + 4 * g + r;
                    const float e = __builtin_amdgcn_exp2f(fminf(z, 80.f)); const float k1 = __builtin_amdgcn_rcpf(1.f + e);
                    const bool ok = kpos < qrow; kp[r] = ok ? k1 : 1.f; be[r] = ok ? e * k1 : 0.f; }
                const float x2 = kp[3], x1 = x2 * kp[2], x0 = x1 * kp[1], tot = x0 * kp[0];
                const float p16 = __shfl_xor(tot, 16), a1 = tot * p16, po = __shfl_xor(a1, 32);
                const float base = cy * ((g & 1) ? 1.f : p16) * ((g < 2) ? po : 1.f);
                w[kb][0] = be[0] * (base * x0); w[kb][1] = be[1] * (base * x1); w[kb][2] = be[2] * (base * x2); w[kb][3] = be[3] * base;
                cy *= a1 * po;
            }
            if (c) carry1 = cy; else carry0 = cy;
            u32x4 pw; pw.x = cvt_pk_bf16(w[0][0], w[0][1]); pw.y = cvt_pk_bf16(w[0][2], w[0][3]); pw.z = cvt_pk_bf16(w[1][0], w[1][1]); pw.w = cvt_pk_bf16(w[1][2], w[1][3]);
            pf[c] = __builtin_bit_cast(bf16x8, pw);
        }
#pragma unroll
        for (int db = 0; db < 8; ++db) { const LAS bf16_t* vb = Vw + (4 * g + (fr >> 2)) * 144 + 16 * db + 4 * (fr & 3);
            const bf16x8 av = cat4(lds_tr16(vb), lds_tr16(vb + 16 * 144));
            oacc[0][db] = mfma16(av, pf[0], oacc[0][db]); oacc[1][db] = mfma16(av, pf[1], oacc[1][db]); }
        if (__all((carry0 == 0.f) && (carry1 == 0.f))) break;
        wave_lds_sync();
    }
#undef AW_LOAD
#pragma unroll
    for (int c = 0; c < 2; ++c) { const size_t tok = tokb + qrow0 + 16 * c;
#pragma unroll
        for (int db = 0; db < 8; ++db) { const int col = h * 128 + 16 * db + 4 * g;
            const u32x2 sz = *(const u32x2*)(P + tok * 7168 + 6144 + col);
            u32x2 w; w.x = cvt_pk_bf16(oacc[c][db][0] * __uint_as_float(sz.x << 16), oacc[c][db][1] * __uint_as_float(sz.x & 0xffff0000u));
            w.y = cvt_pk_bf16(oacc[c][db][2] * __uint_as_float(sz.y << 16), oacc[c][db][3] * __uint_as_float(sz.y & 0xffff0000u));
            *(u32x2*)(MIX + tok * 2048 + 1024 + col) = w; } }
}

__device__ __forceinline__ void phase_mixers(const Params& p, LAS unsigned char* lds) {
    const int G = gridDim.x, wid = __builtin_amdgcn_readfirstlane(threadIdx.x >> 6);
    const int vcu = (G == 256) ? (int)((blockIdx.x & 7) * 32 + (blockIdx.x >> 3)) : (int)blockIdx.x;
    for (int rp_ = 0; rp_ < ATT_REP; ++rp_)
    for (int i = vcu; i < 512; i += G) { const int bh = i >> 4, qb = i & 15; attn_wave_item(p, lds + wid * 18432, bh >> 3, bh & 7, qb * 8 + wid); }
    for (int rp_ = 0; rp_ < SGU_REP; ++rp_)
    for (int i = blockIdx.x; i < 1024; i += G) sgu_item(p, lds, i >> 8, (i >> 3) & 31, i & 7);
}

__device__ __forceinline__ void ssm_coef(const Params& p, int grp, int pp, float& are, float& aim, float& cre, float& cim) {
    const float dt = expf(p.log_dt[grp]); const float lr = p.lam_re[grp * 64 + pp], li = p.lam_im[grp * 64 + pp];
    const float mag = expf(lr * dt); are = mag * cosf(li * dt); aim = mag * sinf(li * dt);
    const float den = lr * lr + li * li, nr = are - 1.f;
    cre = (nr * lr + aim * li) / den; cim = (aim * lr - nr * li) / den;
}
__device__ __forceinline__ void ssm_item(const Params& p, LAS unsigned char* lds, int b, int grp) {
    LAS float* aTab = (LAS float*)lds;
    LAS bf16_t* BmN = (LAS bf16_t*)(lds + 1024);
    LAS bf16_t* CmT = (LAS bf16_t*)(lds + 5376);
    LAS float* S = (LAS float*)(lds + 9728);
    LAS bf16_t* Kt = (LAS bf16_t*)(lds + 42496);
    LAS float* AP = (LAS float*)(lds + 75776);
    const int tid = threadIdx.x, wid = __builtin_amdgcn_readfirstlane(tid >> 6), lane = tid & 63, fr = lane & 15, g = lane >> 4;
    __syncthreads();
    if (tid < 64) { float are, aim, cre, cim; ssm_coef(p, grp, tid, are, aim, cre, cim); aTab[tid] = are; aTab[64 + tid] = aim;
        float pr = are, pi = aim;
#pragma unroll
        for (int i = 0; i < 6; ++i) { const float nr2 = pr * pr - pi * pi, ni2 = 2.f * pr * pi; pr = nr2; pi = ni2; }
        aTab[128 + tid] = pr; aTab[192 + tid] = pi; }
    if (tid < 128) ((LAS unsigned*)Kt)[tid] = 0u;
#pragma unroll
    for (int i = 0; i < 2; ++i) { const int idx = tid + 512 * i, pp = idx >> 4, c = idx & 15; float are, aim, cre, cim; ssm_coef(p, grp, pp, are, aim, cre, cim);
        const float br = p.b_re[((size_t)grp * 64 + pp) * 16 + c], bi = p.b_im[((size_t)grp * 64 + pp) * 16 + c];
        BmN[c * 136 + 2 * pp] = f2bf(cre * br - cim * bi); BmN[c * 136 + 2 * pp + 1] = f2bf(cre * bi + cim * br); }
#pragma unroll
    for (int i = 0; i < 2; ++i) { const int idx = tid + 512 * i, c = idx >> 6, pp = idx & 63;
        CmT[c * 136 + 2 * pp] = f2bf(p.c_re[((size_t)grp * 16 + c) * 64 + pp]); CmT[c * 136 + 2 * pp + 1] = f2bf(-p.c_im[((size_t)grp * 16 + c) * 64 + pp]); }
    {
        const int pp = tid & 63, j8 = tid >> 6; float are, aim, cre, cim; ssm_coef(p, grp, pp, are, aim, cre, cim);
        float cr = 1.f, ci = 0.f;
        for (int i = 0; i < 8 * j8; ++i) { const float nr = cr * are - ci * aim, ni = cr * aim + ci * are; cr = nr; ci = ni; }
        if (j8 == 0) { AP[2 * pp] = 1.f; AP[2 * pp + 1] = 0.f; }
#pragma unroll
        for (int i = 1; i <= 8; ++i) { const float nr = cr * are - ci * aim, ni = cr * aim + ci * are; cr = nr; ci = ni; AP[((8 * j8 + i) * 64 + pp) * 2] = cr; AP[((8 * j8 + i) * 64 + pp) * 2 + 1] = ci; }
    }
    __syncthreads();
    bf16x8 cfr[4];
#pragma unroll
    for (int ks = 0; ks < 4; ++ks) cfr[ks] = *(const LAS bf16x8*)(CmT + fr * 136 + 8 * g + 32 * ks);
    const bf16_t* U = (const bf16_t*)(p.ws + OFF_UG) + (size_t)(b * 64 + grp) * 4096 * 16;
    bf16_t* Gout = (bf16_t*)(p.ws + OFF_MIX) + (size_t)b * SEQ * 1024 + grp * 16;
    const int th = g >> 1, c0 = 8 * (g & 1);
    const int cbw = wid & 3, hh = wid >> 2;
    {
        for (int qh = 0; qh < 2; ++qh) {
        float X[2][8], Y[2][8], a2r[2], a2i[2], apr[2], api[2];
#pragma unroll
        for (int q = 0; q < 2; ++q) { const int pl = 8 * (4 * hh + 2 * qh + q) + (fr >> 1), ri = fr & 1;
            const float are_l = aTab[pl], aim_l = aTab[64 + pl];
#pragma unroll
            for (int j = 0; j < 8; ++j) { const float bbre = bf2f(BmN[(c0 + j) * 136 + 2 * pl]), bbim = bf2f(BmN[(c0 + j) * 136 + 2 * pl + 1]);
                X[q][j] = ri ? bbim : bbre; Y[q][j] = ri ? bbre : -bbim; }
            a2r[q] = are_l * are_l - aim_l * aim_l; a2i[q] = 2.f * are_l * aim_l;
            apr[q] = th ? 1.f : are_l; api[q] = th ? 0.f : aim_l; }
        f32x4 sacc[2];
#pragma unroll
        for (int q = 0; q < 2; ++q) sacc[q] = (f32x4){0.f, 0.f, 0.f, 0.f};
#pragma unroll 4
        for (int ks = 31; ks >= 0; --ks) {
            const bf16x8 bf = *(const bf16x8*)(U + (size_t)(64 * (16 * cbw + fr) + 2 * ks + th) * 16 + c0);
#pragma unroll
            for (int q = 0; q < 2; ++q) {
                u32x4 aw; aw.x = cvt_pk_bf16(apr[q] * X[q][0] + api[q] * Y[q][0], apr[q] * X[q][1] + api[q] * Y[q][1]); aw.y = cvt_pk_bf16(apr[q] * X[q][2] + api[q] * Y[q][2], apr[q] * X[q][3] + api[q] * Y[q][3]);
                aw.z = cvt_pk_bf16(apr[q] * X[q][4] + api[q] * Y[q][4], apr[q] * X[q][5] + api[q] * Y[q][5]); aw.w = cvt_pk_bf16(apr[q] * X[q][6] + api[q] * Y[q][6], apr[q] * X[q][7] + api[q] * Y[q][7]);
                sacc[q] = mfma16(__builtin_bit_cast(bf16x8, aw), bf, sacc[q]);
                const float nr = apr[q] * a2r[q] - api[q] * a2i[q], ni = apr[q] * a2i[q] + api[q] * a2r[q]; apr[q] = nr; api[q] = ni; }
        }
#pragma unroll
        for (int q = 0; q < 2; ++q) *(LAS f32x4*)(S + (16 * cbw + fr) * 128 + 16 * (4 * hh + 2 * qh + q) + 4 * g) = sacc[q];
        }
    }
    {
        float cr[4][4], ci[4][4];
#pragma unroll
        for (int ks = 0; ks < 4; ++ks)
#pragma unroll
            for (int jp = 0; jp < 4; ++jp) { const int pp = 16 * ks + 4 * g + jp; cr[ks][jp] = p.c_re[((size_t)grp * 16 + fr) * 64 + pp]; ci[ks][jp] = p.c_im[((size_t)grp * 16 + fr) * 64 + pp]; }
        bf16x8 bmf[4];
#pragma unroll
        for (int ks = 0; ks < 4; ++ks) bmf[ks] = *(const LAS bf16x8*)(BmN + fr * 136 + 8 * g + 32 * ks);
        for (int li = 0; li < 8; ++li) { const int l = 8 * wid + li;
            f32x4 kacc = (f32x4){0.f, 0.f, 0.f, 0.f};
#pragma unroll
            for (int ks = 0; ks < 4; ++ks) { const LAS f32x4* ap = (const LAS f32x4*)(AP + (l * 64 + 16 * ks + 4 * g) * 2);
                const f32x4 p01 = ap[0], p23 = ap[1];
                const float pr[4] = {p01[0], p01[2], p23[0], p23[2]}, pi[4] = {p01[1], p01[3], p23[1], p23[3]};
                float v[8];
#pragma unroll
                for (int jp = 0; jp < 4; ++jp) { v[2 * jp] = cr[ks][jp] * pr[jp] - ci[ks][jp] * pi[jp]; v[2 * jp + 1] = -(cr[ks][jp] * pi[jp] + ci[ks][jp] * pr[jp]); }
                u32x4 aw; aw.x = cvt_pk_bf16(v[0], v[1]); aw.y = cvt_pk_bf16(v[2], v[3]); aw.z = cvt_pk_bf16(v[4], v[5]); aw.w = cvt_pk_bf16(v[6], v[7]);
                kacc = mfma16(__builtin_bit_cast(bf16x8, aw), bmf[ks], kacc); }
#pragma unroll
            for (int q = 0; q < 4; ++q) Kt[(l + 1) * 256 + (4 * g + q) * 16 + fr] = f2bf(kacc[q]);
        }
    }
    __syncthreads();
    if (wid == 0) { const float Ar = aTab[128 + lane], Ai = aTab[192 + lane]; float rre = 0.f, rim = 0.f;
        for (int ch = 0; ch < 64; ++ch) { const f32x2v sv = *(const LAS f32x2v*)(S + ch * 128 + 2 * lane);
            f32x2v o; o.x = rre; o.y = rim; *(LAS f32x2v*)(S + ch * 128 + 2 * lane) = o;
            const float nre = Ar * rre - Ai * rim + sv.x, nim = Ar * rim + Ai * rre + sv.y; rre = nre; rim = nim; } }
    __syncthreads();
    f32x4 dsk;
#pragma unroll
    for (int q = 0; q < 4; ++q) dsk[q] = p.d_skip[grp * 16 + 4 * g + q];
    f32x4 h01[4], h23[4];
#pragma unroll
    for (int ks = 0; ks < 4; ++ks) { const LAS f32x4* hp = (const LAS f32x4*)(S + (16 * cbw + fr) * 128 + 32 * ks + 8 * g); h01[ks] = hp[0]; h23[ks] = hp[1]; }
    for (int g4 = 0; g4 < 4; ++g4) {
        f32x4 acc[8];
#pragma unroll
        for (int ii = 0; ii < 8; ++ii) acc[ii] = (f32x4){0.f, 0.f, 0.f, 0.f};
#pragma unroll
        for (int ii = 0; ii < 8; ++ii) { const int t = 2 * (8 * g4 + ii) + hh;
#pragma unroll
            for (int ks = 0; ks < 4; ++ks) { const LAS f32x4* ap = (const LAS f32x4*)(AP + ((t + 1) * 64 + 16 * ks + 4 * g) * 2);
                const f32x4 p01 = ap[0], p23 = ap[1];
                u32x4 hw;
                hw.x = cvt_pk_bf16(p01[0] * h01[ks][0] - p01[1] * h01[ks][1], p01[0] * h01[ks][1] + p01[1] * h01[ks][0]);
                hw.y = cvt_pk_bf16(p01[2] * h01[ks][2] - p01[3] * h01[ks][3], p01[2] * h01[ks][3] + p01[3] * h01[ks][2]);
                hw.z = cvt_pk_bf16(p23[0] * h23[ks][0] - p23[1] * h23[ks][1], p23[0] * h23[ks][1] + p23[1] * h23[ks][0]);
                hw.w = cvt_pk_bf16(p23[2] * h23[ks][2] - p23[3] * h23[ks][3], p23[2] * h23[ks][3] + p23[3] * h23[ks][2]);
                acc[ii] = mfma16(cfr[ks], __builtin_bit_cast(bf16x8, hw), acc[ii]); } }
        const int nks = 8 * g4 + 8;
#pragma unroll 2
        for (int ks2 = 0; ks2 < nks; ++ks2) {
            const bf16x8 ub = *(const bf16x8*)(U + (size_t)(64 * (16 * cbw + fr) + 2 * ks2 + th) * 16 + c0);
#pragma unroll
            for (int ii = 0; ii < 8; ++ii) { const int t = 2 * (8 * g4 + ii) + hh;
                int li = t - (2 * ks2 + th) + 1; li = li < 0 ? 0 : li;
                const bf16x8 kf = *(const LAS bf16x8*)(Kt + li * 256 + fr * 16 + c0);
                acc[ii] = mfma16(kf, ub, acc[ii]); }
        }
#pragma unroll
        for (int ii = 0; ii < 8; ++ii) { const int t = 2 * (8 * g4 + ii) + hh; const size_t tok = (size_t)(64 * (16 * cbw + fr) + t);
            const u32x2 u4 = *(const u32x2*)(U + tok * 16 + 4 * g);
            const float o0 = gelu_f(acc[ii][0] + dsk[0] * __uint_as_float(u4.x << 16)), o1 = gelu_f(acc[ii][1] + dsk[1] * __uint_as_float(u4.x & 0xffff0000u));
            const float o2 = gelu_f(acc[ii][2] + dsk[2] * __uint_as_float(u4.y << 16)), o3 = gelu_f(acc[ii][3] + dsk[3] * __uint_as_float(u4.y & 0xffff0000u));
            u32x2 w; w.x = cvt_pk_bf16(o0, o1); w.y = cvt_pk_bf16(o2, o3);
            *(u32x2*)(Gout + tok * 1024 + 4 * g) = w; }
    }
}

#define XB_TMO      128
#define XB_XCNT(j)  (256  + 64 * (j))
#define XB_XSUB(j)  (1280 + 64 * (j))
#define XB_XGEN(j)  (2304 + 64 * (j))
#define XB_TOP      3328
#define XB_TOPGEN   3392
#define XCD_BAR_WORDS 3456
#define XB_SPIN_CAP (1u << 18)

__device__ __forceinline__ unsigned xb_ld(unsigned* p)              { return __hip_atomic_load(p, __ATOMIC_RELAXED, __HIP_MEMORY_SCOPE_AGENT); }
__device__ __forceinline__ unsigned xb_add(unsigned* p, unsigned v) { return __hip_atomic_fetch_add(p, v, __ATOMIC_RELAXED, __HIP_MEMORY_SCOPE_AGENT); }
__device__ __forceinline__ unsigned xb_xcc_id() { return (unsigned)__builtin_amdgcn_s_getreg((3 << 11) | 20) & 0xFu; }
#define XB_SPIN(cond, bar) do { unsigned _sp = 0; while (cond) { __builtin_amdgcn_s_sleep(1); \
    if ((++_sp & 255u) == 0u) { if (xb_ld(&(bar)[XB_TMO])) break; if (_sp > XB_SPIN_CAP) { atomicAdd(&(bar)[XB_TMO], 1u); break; } } } } while (0)

struct XcdBarrier {
    unsigned* bar; unsigned x;
    volatile LAS unsigned* st;
};

__device__ __forceinline__ XcdBarrier xcd_barrier_post(unsigned* bar, volatile LAS unsigned* st) {
    XcdBarrier b; b.bar = bar; b.x = xb_xcc_id(); b.st = st;
    if (threadIdx.x == 0) (void)xb_add(&bar[XB_XCNT(b.x)], 1u);
    return b;
}
__device__ __forceinline__ void xcd_barrier_complete(unsigned* bar, unsigned x, unsigned& nloc, unsigned& nx) {
    const unsigned G = gridDim.x * gridDim.y * gridDim.z;
    unsigned sum, cnt, mine, sp = 0u;
    for (;;) {
        sum = 0u; cnt = 0u; mine = 0u;
#pragma unroll
        for (unsigned j = 0; j < 16; ++j) { const unsigned c = xb_ld(&bar[XB_XCNT(j)]); sum += c; cnt += (c > 0u) ? 1u : 0u; mine = (j == x) ? c : mine; }
        if (sum == G) break;
        __builtin_amdgcn_s_sleep(1);
        if ((++sp & 255u) == 0u) { if (xb_ld(&bar[XB_TMO])) break; if (sp > XB_SPIN_CAP) { atomicAdd(&bar[XB_TMO], 1u); break; } }
    }
    nloc = mine > 0u ? mine : 1u; nx = cnt > 0u ? cnt : 1u;
}

__device__ __forceinline__ void xcd_barrier(const XcdBarrier& b) {
    asm volatile("s_waitcnt vmcnt(0)" ::: "memory");
    __syncthreads();
    if (threadIdx.x == 0) {
        unsigned* bar = b.bar;
        __builtin_amdgcn_s_waitcnt(0);
        unsigned nloc = b.st[0], nx = b.st[1];
        if (nloc == 0u) { xcd_barrier_complete(bar, b.x, nloc, nx); b.st[0] = nloc; b.st[1] = nx; }
        const unsigned old = xb_add(&bar[XB_XSUB(b.x)], 1u);
        const unsigned gen = old / nloc;
        if (old + 1u == (gen + 1u) * nloc) {
            __builtin_amdgcn_fence(__ATOMIC_RELEASE, "agent");
            asm volatile("s_waitcnt vmcnt(0)" ::: "memory");
            const unsigned og = xb_add(&bar[XB_TOP], 1u);
            const unsigned tg = og / nx;
            if (og + 1u == (tg + 1u) * nx) xb_add(&bar[XB_TOPGEN], 1u);
            else XB_SPIN(xb_ld(&bar[XB_TOPGEN]) == tg, bar);
            __builtin_amdgcn_fence(__ATOMIC_ACQUIRE, "agent");
            xb_add(&bar[XB_XGEN(b.x)], 1u);
            asm volatile("s_waitcnt vmcnt(0)" ::: "memory");
        } else {
            XB_SPIN(xb_ld(&bar[XB_XGEN(b.x)]) == gen, bar);
            __builtin_amdgcn_fence(__ATOMIC_ACQUIRE, "agent");
            asm volatile("s_waitcnt vmcnt(0)" ::: "memory");
        }
    }
    __syncthreads();
}


template <int MODE> __device__ __forceinline__ void run_gemm(unsigned char* ws_, LAS unsigned char* lds, const bf16_t* A, const bf16_t* Bt, int N, int K, bf16_t* O, int ldc, const float* bias, const bf16_t* Gp, const bf16_t* UZp) {
    pg8::Gemm gm; gm.A = A; gm.Bt = Bt; gm.M = NTOK; gm.N = N; gm.K = K;
    pg8::StaticOrder S; S.init(NTOK, N, (int)gridDim.x, (int)blockIdx.x);
    pg8::EpiM<MODE> E; E.O = O; E.ldc = ldc; E.bias = bias; E.G = Gp; E.UZ = UZp; E.UG = (bf16_t*)(ws_ + OFF_UG); E.qscale = 0.12751743082459868f;
    pg8::gemm_phase<pg8::EpiM<MODE>, pg8::StaticOrder, GEMM_ALIGN, GEMM_SP2>(lds, gm, S, E);
}

#ifndef PHASE_MASK
#define PHASE_MASK 0x7ff
#endif
constexpr int N_PHASES = 11;
__global__ __launch_bounds__(512, 2) void mega_fwd(Params p, int ph_lo, int ph_hi) {
    extern __shared__ __attribute__((aligned(16))) unsigned char shm[];
    LAS unsigned char* lds = (LAS unsigned char*)shm;
    cg::grid_group grid = cg::this_grid();
    unsigned char* ws = p.ws;
    volatile LAS unsigned* xst = (volatile LAS unsigned*)(lds + LDS_BYTES - 16);
    if (threadIdx.x == 0) { xst[0] = 0u; xst[1] = 0u; }
    __syncthreads();
    const XcdBarrier xb = xcd_barrier_post((unsigned*)ws, xst);
    if (ph_lo < 0) grid.sync();
#ifndef REPEAT_MASK
#define REPEAT_MASK 0
#endif
#define PH_BEGIN(k) if (ph_lo <= (k) && (k) < ph_hi) { if ((k) > ph_lo) xcd_barrier(xb); for (int rep_ = 0; rep_ <= ((REPEAT_MASK >> (k)) & 1); ++rep_) {
#define PH_END }}
    PH_BEGIN(0) phase_mod(p, lds); PH_END
    PH_BEGIN(1) phase_rows<0>(p, lds); phase_transposes(p, lds); PH_END
    PH_BEGIN(2) run_gemm<0>(ws, lds, (const bf16_t*)(ws + OFF_HB), (const bf16_t*)(ws + OFF_W1T), 7168, 2048, (bf16_t*)(ws + OFF_PROJ), 7168, nullptr, nullptr, nullptr); PH_END
    PH_BEGIN(3) phase_mixers(p, lds); PH_END
    PH_BEGIN(4) run_gemm<1>(ws, lds, (const bf16_t*)(ws + OFF_MIX), (const bf16_t*)(ws + OFF_W2T), 2048, 2048, (bf16_t*)(ws + OFF_Y0), 2048, nullptr, nullptr, nullptr); PH_END
    PH_BEGIN(5) phase_rows<1>(p, lds); PH_END
    PH_BEGIN(6) run_gemm<2>(ws, lds, (const bf16_t*)(ws + OFF_HB), (const bf16_t*)(ws + OFF_W3T), 2048, 2048, (bf16_t*)(ws + OFF_UZ), 2048, nullptr, nullptr, nullptr); PH_END
    PH_BEGIN(7) for (int it = blockIdx.x; it < 256; it += gridDim.x) ssm_item(p, lds, it >> 6, it & 63); PH_END
    PH_BEGIN(8) run_gemm<3>(ws, lds, (const bf16_t*)(ws + OFF_MIX), (const bf16_t*)(ws + OFF_W4T), 1024, 1024, (bf16_t*)(ws + OFF_MIX) + (size_t)NTOK * 1024, 1024, p.b_glu, (const bf16_t*)(ws + OFF_MIX), (const bf16_t*)(ws + OFF_UZ)); PH_END
    PH_BEGIN(9) run_gemm<1>(ws, lds, (const bf16_t*)(ws + OFF_MIX) + (size_t)NTOK * 1024, (const bf16_t*)(ws + OFF_W5T), 2048, 1024, (bf16_t*)(ws + OFF_Y1), 2048, nullptr, nullptr, nullptr); PH_END
    PH_BEGIN(10) phase_rows<2>(p, lds); PH_END
}

extern "C" void kernel_launch(void* const* d_in, const int* in_sizes, int n_in, void* d_out, int out_size, void* d_ws, size_t ws_size, hipStream_t stream) {
    static int grid = 0;
    if (grid == 0) {
        if (n_in != 23 || out_size != NTOK * DM || ws_size < WS_END) { fprintf(stderr, "kernel_launch: unexpected shapes (n_in %d out %d ws %zu need %zu)\n", n_in, out_size, ws_size, (size_t)WS_END); grid = -1; return; }
        int dev = 0, cus = 0, per_cu = 0;
        (void)hipGetDevice(&dev); (void)hipDeviceGetAttribute(&cus, hipDeviceAttributeMultiprocessorCount, dev);
        if (hipFuncSetAttribute((const void*)mega_fwd, hipFuncAttributeMaxDynamicSharedMemorySize, LDS_BYTES) != hipSuccess) { fprintf(stderr, "kernel_launch: hipFuncSetAttribute failed\n"); grid = -1; return; }
        if (hipOccupancyMaxActiveBlocksPerMultiprocessor(&per_cu, (const void*)mega_fwd, 512, LDS_BYTES) != hipSuccess || per_cu < 1) { fprintf(stderr, "kernel_launch: occupancy query says %d\n", per_cu); per_cu = 1; }
        (void)hipGetLastError();
        grid = cus * 1;
        fprintf(stderr, "kernel_launch: grid %d (cus %d, per_cu %d)\n", grid, cus, per_cu);
    }
    if (grid < 0) return;
    if (hipMemsetAsync((char*)d_ws + OFF_BAR, 0, 16384, stream) != hipSuccess) { fprintf(stderr, "kernel_launch: memset of the barrier words failed\n"); return; }
    Params p{};
    const float** pp = (const float**)&p;
    for (int i = 0; i < 23; ++i) pp[i] = (const float*)d_in[i];
    p.out = (float*)d_out; p.ws = (unsigned char*)d_ws;
#if MULTI_LAUNCH
    for (int ph = 0; ph < N_PHASES; ++ph) {
        hipLaunchKernelGGL(mega_fwd, dim3(grid), dim3(512), LDS_BYTES, stream, p, ph, ph + 1);
    }
#else
    int lo = 0, hi = N_PHASES;
    void* args[] = {(void*)&p, (void*)&lo, (void*)&hi};
    hipError_t e = hipLaunchCooperativeKernel((const void*)mega_fwd, dim3(grid), dim3(512), args, LDS_BYTES, stream);
    if (e != hipSuccess) fprintf(stderr, "cooperative launch failed: %s (grid %d)\n", hipGetErrorString(e), grid);
#endif
}
```

```cpp
#include <hip/hip_runtime.h>
#include <hip/hip_cooperative_groups.h>
#include <cstdio>
#include <cstdint>
namespace cg = cooperative_groups;

#ifndef GEMM_ALIGN
#define GEMM_ALIGN true
#endif
#ifndef GEMM_SP2
#define GEMM_SP2 true
#endif
#ifndef ATT_REP
#define ATT_REP 1
#endif
#ifndef SGU_REP
#define SGU_REP 1
#endif
#ifndef MULTI_LAUNCH
#define MULTI_LAUNCH 0
#endif

namespace pg8 {
#define PG8_LAS __attribute__((address_space(3)))
typedef unsigned short bf16_t;
typedef short bf16x8 __attribute__((ext_vector_type(8)));
typedef float f32x4 __attribute__((ext_vector_type(4)));
typedef unsigned u32x4 __attribute__((ext_vector_type(4)));
constexpr int BM = 256, BK = 64, HALF = 128, HTB = HALF * BK * 2  , STAGE_BYTES = 8 * HTB, NXCD = 8, WGM = 2;

__host__ __device__ __forceinline__ int lds_byte(int r, int c) { const int st = (r >> 4) * 2 + (c >> 5), rr = r & 15, cc = c & 31, ob = rr * 64 + cc * 2; return st * 1024 + (ob ^ (((ob >> 9) & 1) << 5)); }
__host__ __device__ __forceinline__ void stage_rc(int b, int& R, int& C) { const int st = b / 1024, sb = b % 1024, swz = sb ^ (((sb >> 9) & 1) << 5); R = (st >> 1) * 16 + swz / 64; C = (st & 1) * 32 + (swz % 64) / 2; }
__host__ __device__ __forceinline__ int perm32(int rho) { const int n = rho >> 4, i = rho & 15; return 8 * (i >> 2) + 4 * n + (i & 3); }

struct Unit { int pm, pn; };
struct Gemm { const bf16_t* A; const bf16_t* Bt; int M, N, K; };

struct StaticOrder {
    int nM, nN, nwg, G, c;
    __host__ __device__ void init(int M, int N, int G_, int c_) { nM = M / BM; nN = N / BM; nwg = nM * nN; G = G_; c = c_; }
    __host__ __device__ bool next(int i, Unit& u) const {
        const long L = (long)i * G + c; if (L >= nwg) return false;
        int wgid = (int)L; { const int q = nwg / NXCD, r = nwg % NXCD, xcd = wgid % NXCD, off = wgid / NXCD; wgid = (xcd < r ? xcd * (q + 1) : r * (q + 1) + (xcd - r) * q) + off; }
        const int nig = WGM * nN, gid = wgid / nig, fm = gid * WGM, gsz = (nM - fm) < WGM ? (nM - fm) : WGM;
        u.pm = fm + ((wgid % nig) % gsz); u.pn = (wgid % nig) / gsz; return true;
    }
    __device__ __forceinline__ void a_ready(const Unit&) const {}
    __device__ __forceinline__ void done(const Unit&) const {}
};


__device__ __forceinline__ unsigned cvt_pk_bf16(float lo, float hi) { unsigned r; asm volatile("v_cvt_pk_bf16_f32 %0, %1, %2" : "=v"(r) : "v"(lo), "v"(hi)); return r; }

template <class Epi, class Sched, bool ALIGN_EPI = false, bool SP2 = false>
__device__ __forceinline__ void gemm_phase(PG8_LAS unsigned char* lds, const Gemm g, const Sched& S, const Epi& E) {
    const int tid = threadIdx.x, wid = __builtin_amdgcn_readfirstlane(tid >> 6), lane = tid & 63, wr = wid >> 2, wc = wid & 3, fr = lane & 15, fq = lane >> 4;
    const int K = g.K, nt = K / BK;
    unsigned voffA[2], voffB[2];
#pragma unroll
    for (int i = 0; i < 2; ++i) { int R, C; stage_rc(tid * 16 + i * 8192, R, C); const int Rb = Epi::PERM ? ((R & ~31) + perm32(R & 31)) : R;
        voffA[i] = (unsigned)(R * K + C) * 2u; voffB[i] = (unsigned)(Rb * K + C) * 2u; }
    const size_t kstep = (size_t)(BK * 2);
    const size_t hstep = (size_t)HALF * K * 2;
    const size_t tstep = 2 * hstep;
    const unsigned ldsw = (unsigned)wid * 1024u;
    const int aoff = lds_byte(wr * 64 + fr, fq * 8), boff = lds_byte(wc * 32 + fr, fq * 8);
#define PG8_SA(b, h) (((b) * 2 + (h)) * HTB)
#define PG8_SB(b, h) ((4 + (b) * 2 + (h)) * HTB)
#define PG8_STAGE(bufoff, gbase, voff) do { _Pragma("unroll") for (int _i = 0; _i < 2; ++_i) \
        __builtin_amdgcn_global_load_lds((const unsigned*)((const char*)(gbase) + (voff)[_i]), (PG8_LAS unsigned*)(lds + (bufoff) + ldsw + _i * 8192), 16, 0, 0); } while (0)
#define PG8_LDA(dst, b, h) do { _Pragma("unroll") for (int m = 0; m < 4; ++m) _Pragma("unroll") for (int k = 0; k < 2; ++k) dst[m][k] = *(const PG8_LAS bf16x8*)(lds + PG8_SA(b, h) + aoff + m * 2048 + k * 1024); } while (0)
#define PG8_LDB(dst, b, h) do { _Pragma("unroll") for (int n = 0; n < 2; ++n) _Pragma("unroll") for (int k = 0; k < 2; ++k) dst[n][k] = *(const PG8_LAS bf16x8*)(lds + PG8_SB(b, h) + boff + n * 2048 + k * 1024); } while (0)
#define PG8_MMA(ai, bj, At, Bt) do { __builtin_amdgcn_s_setprio(1); _Pragma("unroll") for (int m = 0; m < 4; ++m) _Pragma("unroll") for (int n = 0; n < 2; ++n) _Pragma("unroll") for (int k = 0; k < 2; ++k) \
        acc[ai][bj][m][n] = __builtin_amdgcn_mfma_f32_16x16x32_bf16(Bt[n][k], At[m][k], acc[ai][bj][m][n], 0, 0, 0); __builtin_amdgcn_s_setprio(0); } while (0)
#define PG8_WAIT_V(n) asm volatile("s_waitcnt vmcnt(" #n ")" ::: "memory")
#define PG8_WAIT_L(n) asm volatile("s_waitcnt lgkmcnt(" #n ")" ::: "memory")
#define PG8_BAR __builtin_amdgcn_s_barrier()
#define PG8_SCHED __builtin_amdgcn_sched_barrier(0)
    Unit cur, nxt; int ui = 0;
    if (!S.next(0, cur)) return;
    f32x4 acc[2][2][4][2];
#pragma unroll
    for (int a = 0; a < 2; ++a)
#pragma unroll
        for (int b = 0; b < 2; ++b)
#pragma unroll
            for (int m = 0; m < 4; ++m)
#pragma unroll
                for (int n = 0; n < 2; ++n) acc[a][b][m][n] = (f32x4){0.f, 0.f, 0.f, 0.f};
    bf16x8 At[4][2], B0[2][2], B1[2][2];
    const char* cA = (const char*)g.A + (size_t)cur.pm * tstep; const char* cB = (const char*)g.Bt + (size_t)cur.pn * tstep;
    S.a_ready(cur);
    if constexpr (SP2) {
        PG8_STAGE(PG8_SB(0, 0), cB, voffB); PG8_STAGE(PG8_SB(0, 1), cB + hstep, voffB); PG8_STAGE(PG8_SA(0, 0), cA, voffA); PG8_STAGE(PG8_SA(0, 1), cA + hstep, voffA);
        if (wr == 1) PG8_BAR;
        PG8_WAIT_V(2); PG8_BAR;
        PG8_STAGE(PG8_SB(1, 0), cB + kstep, voffB); PG8_STAGE(PG8_SA(1, 0), cA + kstep, voffA); PG8_STAGE(PG8_SB(1, 1), cB + hstep + kstep, voffB);
        PG8_WAIT_V(6); PG8_BAR;
    } else {
        PG8_STAGE(PG8_SB(0, 0), cB, voffB); PG8_STAGE(PG8_SA(0, 0), cA, voffA); PG8_STAGE(PG8_SB(0, 1), cB + hstep, voffB); PG8_STAGE(PG8_SA(0, 1), cA + hstep, voffA);
        if (wr == 1) PG8_BAR;
        PG8_WAIT_V(4); PG8_BAR;
        PG8_STAGE(PG8_SB(1, 0), cB + kstep, voffB); PG8_STAGE(PG8_SA(1, 0), cA + kstep, voffA); PG8_STAGE(PG8_SB(1, 1), cB + hstep + kstep, voffB);
        PG8_WAIT_V(6); PG8_BAR;
    }
    for (;;) {
        const bool has_next = S.next(ui + 1, nxt);
        const char* nA = has_next ? (const char*)g.A + (size_t)nxt.pm * tstep : cA; const char* nB = has_next ? (const char*)g.Bt + (size_t)nxt.pn * tstep : cB;
        for (int t = 0; t < nt; t += 2) {
            const bool last = (t == nt - 2);
            const char* a1 = cA + (size_t)(t + 1) * kstep;
            const char* a2 = last ? nA : cA + (size_t)(t + 2) * kstep; const char* b2 = last ? nB : cB + (size_t)(t + 2) * kstep;
            const char* a3 = a2 + kstep; const char* b3 = b2 + kstep;
            if (last && has_next) S.a_ready(nxt);
            if constexpr (SP2) {
            PG8_LDB(B0, 0, 0); PG8_LDB(B1, 0, 1); PG8_SCHED; PG8_LDA(At, 0, 0); PG8_STAGE(PG8_SA(1, 1), a1 + hstep, voffA);
            PG8_WAIT_V(8); PG8_WAIT_L(0); PG8_BAR; PG8_MMA(0, 0, At, B0); PG8_MMA(0, 1, At, B1); PG8_BAR; PG8_SCHED;
            PG8_LDA(At, 0, 1); PG8_STAGE(PG8_SB(0, 0), b2, voffB); PG8_STAGE(PG8_SB(0, 1), b2 + hstep, voffB); PG8_STAGE(PG8_SA(0, 0), a2, voffA);
            PG8_WAIT_V(8); PG8_WAIT_L(0); PG8_BAR; PG8_MMA(1, 0, At, B0); PG8_MMA(1, 1, At, B1); PG8_BAR; PG8_SCHED;
            PG8_LDB(B0, 1, 0); PG8_LDB(B1, 1, 1); PG8_SCHED; PG8_LDA(At, 1, 0); PG8_STAGE(PG8_SA(0, 1), a2 + hstep, voffA);
            PG8_WAIT_V(8); PG8_WAIT_L(0); PG8_BAR; PG8_MMA(0, 0, At, B0); PG8_MMA(0, 1, At, B1); PG8_BAR; PG8_SCHED;
            PG8_LDA(At, 1, 1); PG8_STAGE(PG8_SB(1, 0), b3, voffB); PG8_STAGE(PG8_SB(1, 1), b3 + hstep, voffB); PG8_STAGE(PG8_SA(1, 0), a3, voffA);
            PG8_WAIT_V(8); PG8_WAIT_L(0); PG8_BAR; PG8_MMA(1, 0, At, B0); PG8_MMA(1, 1, At, B1); PG8_BAR; PG8_SCHED;
            } else {
            PG8_LDB(B0, 0, 0); PG8_SCHED; PG8_LDA(At, 0, 0); PG8_STAGE(PG8_SA(1, 1), a1 + hstep, voffA);
            PG8_WAIT_L(8); PG8_BAR; PG8_WAIT_L(0); PG8_MMA(0, 0, At, B0); PG8_BAR; PG8_SCHED;
            PG8_LDB(B1, 0, 1); PG8_STAGE(PG8_SB(0, 0), b2, voffB);
            PG8_BAR; PG8_WAIT_L(0); PG8_MMA(0, 1, At, B1); PG8_BAR;
            PG8_LDA(At, 0, 1); PG8_STAGE(PG8_SA(0, 0), a2, voffA);
            PG8_BAR; PG8_WAIT_L(0); PG8_MMA(1, 0, At, B0); PG8_BAR; PG8_SCHED;
            PG8_STAGE(PG8_SB(0, 1), b2 + hstep, voffB);
            PG8_WAIT_V(6); PG8_BAR; PG8_MMA(1, 1, At, B1); PG8_BAR;
            PG8_LDB(B0, 1, 0); PG8_SCHED; PG8_LDA(At, 1, 0); PG8_STAGE(PG8_SA(0, 1), a2 + hstep, voffA);
            PG8_WAIT_L(8); PG8_BAR; PG8_WAIT_L(0); PG8_MMA(0, 0, At, B0); PG8_BAR; PG8_SCHED;
            PG8_LDB(B1, 1, 1); PG8_STAGE(PG8_SB(1, 0), b3, voffB);
            PG8_BAR; PG8_WAIT_L(0); PG8_MMA(0, 1, At, B1); PG8_BAR;
            PG8_LDA(At, 1, 1); PG8_STAGE(PG8_SA(1, 0), a3, voffA);
            PG8_BAR; PG8_WAIT_L(0); PG8_MMA(1, 0, At, B0); PG8_BAR; PG8_SCHED;
            PG8_STAGE(PG8_SB(1, 1), b3 + hstep, voffB);
            PG8_WAIT_V(6); PG8_BAR; PG8_MMA(1, 1, At, B1); PG8_BAR;
            }
        }
        if constexpr (ALIGN_EPI) { if (wr == 0) PG8_BAR; }
        if constexpr (!Epi::AFTER_DRAIN) { E(acc, cur, wr, wc, fr, fq); S.done(cur); }
        if (!has_next) break;
#pragma unroll
        for (int a = 0; a < 2; ++a)
#pragma unroll
            for (int b = 0; b < 2; ++b)
#pragma unroll
                for (int m = 0; m < 4; ++m)
#pragma unroll
                    for (int n = 0; n < 2; ++n) acc[a][b][m][n] = (f32x4){0.f, 0.f, 0.f, 0.f};
        cur = nxt; cA = nA; cB = nB; ++ui;
        if constexpr (ALIGN_EPI) { if (wr == 1) PG8_BAR; }
    }
    PG8_WAIT_V(0);
    if constexpr (!ALIGN_EPI) { if (wr == 0) PG8_BAR; }
    PG8_BAR;
    if constexpr (Epi::AFTER_DRAIN) { E.fused(acc, cur, wr, wc, fr, fq, lds, wid, lane); S.done(cur); }
#undef PG8_SA
#undef PG8_SB
#undef PG8_STAGE
#undef PG8_LDA
#undef PG8_LDB
#undef PG8_MMA
#undef PG8_WAIT_V
#undef PG8_WAIT_L
#undef PG8_BAR
#undef PG8_SCHED
}

__device__ __forceinline__ float bf2f(unsigned short b) { return __uint_as_float(((unsigned)b) << 16); }
__device__ __forceinline__ unsigned short f2bf(float f) { unsigned u = __float_as_uint(f); u += 0x7FFFu + ((u >> 16) & 1u); return (unsigned short)(u >> 16); }
__device__ __forceinline__ float sigmoid_f(float x) { return __builtin_amdgcn_rcpf(1.f + __expf(-x)); }
__device__ __forceinline__ float silu_f(float x) { return x * sigmoid_f(x); }
__device__ __forceinline__ float gelu_f(float x) { const float u = 0.7978845608028654f * (x + 0.044715f * x * x * x); return x * sigmoid_f(2.f * u); }

template <int MODE> struct EpiM {
    static constexpr bool PERM = true, AFTER_DRAIN = false;
    bf16_t* O; int ldc; const float* bias; const bf16_t* G; const bf16_t* UZ; float qscale; bf16_t* UG;
    __device__ __forceinline__ void operator()(const f32x4 (&acc)[2][2][4][2], const Unit& u, int wr, int wc, int fr, int fq) const {
        const int row0 = u.pm * BM + wr * 64 + fr; const int colt = u.pn * BM; const int col0 = colt + wc * 32 + 8 * fq;
        int act = 0;
        if (MODE == 0) { const int seg = colt >> 10; act = (seg <= 1) ? 1 : ((seg == 2 || seg == 6) ? 2 : (seg == 3 ? 3 : 0)); }
        if (MODE == 2) { act = (colt >= 1024) ? 2 : 0; }
#pragma unroll
        for (int ai = 0; ai < 2; ++ai)
#pragma unroll
            for (int m = 0; m < 4; ++m) {
                const int row = row0 + ai * HALF + m * 16;
#pragma unroll
                for (int bj = 0; bj < 2; ++bj) {
                    const int col = col0 + bj * HALF;
                    float v[8];
#pragma unroll
                    for (int j = 0; j < 4; ++j) { v[j] = acc[ai][bj][m][0][j]; v[4 + j] = acc[ai][bj][m][1][j]; }
                    if (MODE == 0 || MODE == 2) {
                        if (act == 1) {
#pragma unroll
                            for (int j = 0; j < 8; ++j) v[j] = gelu_f(v[j]);
                        } else if (act == 2) {
#pragma unroll
                            for (int j = 0; j < 8; ++j) v[j] = silu_f(v[j]);
                        } else if (act == 3) {
#pragma unroll
                            for (int j = 0; j < 8; ++j) v[j] = v[j] * qscale;
                        }
                    }
                    if (MODE == 3) {
                        const f32x4 b0 = *(const f32x4*)(bias + col), b1 = *(const f32x4*)(bias + col + 4);
                        const bf16x8 gv = *(const bf16x8*)(G + (size_t)row * 1024 + col);
                        const bf16x8 zv = *(const bf16x8*)(UZ + (size_t)row * 2048 + 1024 + col);
#pragma unroll
                        for (int j = 0; j < 8; ++j) { const float t = v[j] + (j < 4 ? b0[j & 3] : b1[j & 3]); v[j] = bf2f((unsigned short)gv[j]) * sigmoid_f(t) * bf2f((unsigned short)zv[j]); }
                    }
                    u32x4 w; w.x = cvt_pk_bf16(v[0], v[1]); w.y = cvt_pk_bf16(v[2], v[3]); w.z = cvt_pk_bf16(v[4], v[5]); w.w = cvt_pk_bf16(v[6], v[7]);
                    if (MODE == 2 && colt < 1024) *(u32x4*)(UG + ((size_t)((row >> 12) * 64 + (col >> 4)) * 4096 + (row & 4095)) * 16 + (col & 15)) = w;
                    else *(u32x4*)(O + (size_t)row * ldc + col) = w;
                }
            }
    }
};
}

using pg8::bf16_t; using pg8::bf16x8; using pg8::f32x4; using pg8::u32x4; using pg8::bf2f; using pg8::f2bf; using pg8::silu_f; using pg8::gelu_f; using pg8::sigmoid_f; using pg8::cvt_pk_bf16;
#define LAS __attribute__((address_space(3)))
typedef unsigned u32x2 __attribute__((ext_vector_type(2)));
typedef float f32x2v __attribute__((ext_vector_type(2)));

constexpr int NTOK = 16384, DM = 2048, SEQ = 4096;
constexpr float EPS = 1e-6f;
constexpr int LDS_BYTES = 148480;
constexpr size_t OFF_BAR = 0;
constexpr size_t OFF_MODP = 16384;
constexpr size_t OFF_W1T = OFF_MODP + (size_t)8 * 2 * 4 * 6144 * 4;
constexpr size_t OFF_W2T = OFF_W1T + (size_t)7168 * 2048 * 2;
constexpr size_t OFF_W3T = OFF_W2T + (size_t)2048 * 2048 * 2;
constexpr size_t OFF_W4T = OFF_W3T + (size_t)2048 * 2048 * 2;
constexpr size_t OFF_W5T = OFF_W4T + (size_t)1024 * 1024 * 2;
constexpr size_t OFF_HB = OFF_W5T + (size_t)2048 * 1024 * 2;
constexpr size_t OFF_MIX = OFF_HB + (size_t)NTOK * 2048 * 2;
constexpr size_t OFF_PROJ = OFF_MIX + (size_t)NTOK * 2048 * 2;
constexpr size_t OFF_Y0 = OFF_PROJ;
constexpr size_t OFF_UZ = OFF_Y0 + (size_t)NTOK * 2048 * 2;
constexpr size_t OFF_Y1 = OFF_UZ + (size_t)NTOK * 2048 * 2;
constexpr size_t OFF_UG = OFF_Y1 + (size_t)NTOK * 2048 * 2;
constexpr size_t WS_END = OFF_PROJ + (size_t)NTOK * 7168 * 2;
static_assert(OFF_UG + (size_t)NTOK * 1024 * 2 <= WS_END, "workspace map");

struct Params {
    const float *x, *c, *ln_pre_g, *ln_post_g, *w_mod, *b_mod, *w_in_ab, *w_out_ab, *sgu_norm_g, *sgu_w, *sgu_b,
        *w_in_ssm, *w_out_ssm, *lam_re, *lam_im, *b_re, *b_im, *c_re, *c_im, *d_skip, *log_dt, *w_glu, *b_glu;
    float* out; unsigned char* ws;
};

__device__ __forceinline__ float wave_sum(float v) {
#pragma unroll
    for (int o = 1; o < 64; o <<= 1) v += __shfl_xor(v, o);
    return v;
}
__device__ __forceinline__ void wave_lds_sync() { asm volatile("s_waitcnt lgkmcnt(0)" ::: "memory"); }
typedef short s16x4 __attribute__((ext_vector_type(4)));
__device__ __forceinline__ s16x4 lds_tr16(const LAS bf16_t* p) { return __builtin_amdgcn_ds_read_tr16_b64_v4i16((LAS s16x4*)p); }
__device__ __forceinline__ bf16x8 cat4(s16x4 lo, s16x4 hi) { return __builtin_shufflevector(lo, hi, 0, 1, 2, 3, 4, 5, 6, 7); }
__device__ __forceinline__ f32x4 mfma16(bf16x8 a, bf16x8 b, f32x4 c) { return __builtin_amdgcn_mfma_f32_16x16x32_bf16(a, b, c, 0, 0, 0); }

__device__ __forceinline__ void phase_mod(const Params& p, LAS unsigned char* lds) {
    LAS float* sc = (LAS float*)lds;
    LAS float* part = sc + 8192;
    const int tid = threadIdx.x;
    for (int i = tid; i < 8192; i += 512) sc[i] = silu_f(p.c[i]);
    __syncthreads();
    float* MOD = (float*)(p.ws + OFF_MODP);
    for (int cb = blockIdx.x; cb < 256; cb += gridDim.x) {
        const int l = cb >> 7, col0 = (cb & 127) * 48, q = tid % 12, kg = tid / 12;
        if (kg < 42) {
            f32x4 acc[4];
#pragma unroll
            for (int b = 0; b < 4; ++b) acc[b] = (f32x4){0.f, 0.f, 0.f, 0.f};
            const float* W = p.w_mod + (size_t)l * 2048 * 6144 + col0 + 4 * q;
#pragma unroll 8
            for (int k = kg; k < 2048; k += 42) { const f32x4 w = __builtin_nontemporal_load((const f32x4*)(W + (size_t)k * 6144));
#pragma unroll
                for (int b = 0; b < 4; ++b) { const float sv = sc[b * 2048 + k]; acc[b] += w * sv; } }
#pragma unroll
            for (int b = 0; b < 4; ++b) *(LAS f32x4*)(part + (kg * 4 + b) * 48 + 4 * q) = acc[b];
        }
        __syncthreads();
        if (tid < 192) { const int b = tid / 48, c = tid % 48; float sm = p.b_mod[l * 6144 + col0 + c];
            for (int g2 = 0; g2 < 42; ++g2) sm += part[(g2 * 4 + b) * 48 + c];
            MOD[((size_t)l * 4 + b) * 6144 + col0 + c] = sm; }
        __syncthreads();
    }
}
__device__ __forceinline__ void transpose_item(const float* W, int K, int N, bf16_t* WT, LAS float* scr, int item, int lane) {
    const int nblk = N / 32, kb = item / nblk, nb = item % nblk, k0 = 64 * kb, n0 = 32 * nb;
#pragma unroll
    for (int i = 0; i < 32; ++i) { const int kk = 2 * i + (lane >> 5); scr[kk * 33 + (lane & 31)] = __builtin_nontemporal_load(W + (size_t)(k0 + kk) * N + n0 + (lane & 31)); }
    wave_lds_sync();
    const int c = lane & 7;
#pragma unroll
    for (int j = 0; j < 4; ++j) { const int n = (lane >> 3) + 8 * j; const LAS float* sp = scr + (8 * c) * 33 + n;
        u32x4 o; o.x = cvt_pk_bf16(sp[0 * 33], sp[1 * 33]); o.y = cvt_pk_bf16(sp[2 * 33], sp[3 * 33]); o.z = cvt_pk_bf16(sp[4 * 33], sp[5 * 33]); o.w = cvt_pk_bf16(sp[6 * 33], sp[7 * 33]);
        *(u32x4*)(WT + (size_t)(n0 + n) * K + k0 + 8 * c) = o; }
    wave_lds_sync();
}
__device__ __forceinline__ void phase_transposes(const Params& p, LAS unsigned char* lds) {
    const int tid = threadIdx.x, wid = __builtin_amdgcn_readfirstlane(tid >> 6), lane = tid & 63;
    LAS float* scr = (LAS float*)(lds + 32768 + wid * 8448);
    constexpr int I1 = 32 * 224, I2 = 32 * 64, I3 = 32 * 64, I4 = 16 * 32, I5 = 16 * 64, NITEMS = I1 + I2 + I3 + I4 + I5;
    const int gw = blockIdx.x * 8 + wid, NW = gridDim.x * 8;
    for (int it = gw; it < NITEMS; it += NW) {
        int r = it;
        if (r < I1) { transpose_item(p.w_in_ab, 2048, 7168, (bf16_t*)(p.ws + OFF_W1T), scr, r, lane); continue; } r -= I1;
        if (r < I2) { transpose_item(p.w_out_ab, 2048, 2048, (bf16_t*)(p.ws + OFF_W2T), scr, r, lane); continue; } r -= I2;
        if (r < I3) { transpose_item(p.w_in_ssm, 2048, 2048, (bf16_t*)(p.ws + OFF_W3T), scr, r, lane); continue; } r -= I3;
        if (r < I4) { transpose_item(p.w_glu, 1024, 1024, (bf16_t*)(p.ws + OFF_W4T), scr, r, lane); continue; } r -= I4;
        transpose_item(p.w_out_ssm, 1024, 2048, (bf16_t*)(p.ws + OFF_W5T), scr, r, lane);
    }
}

__device__ __forceinline__ float mod_val(const Params& p, int l, int b, int j) { return ((const float*)(p.ws + OFF_MODP))[((size_t)l * 4 + b) * 6144 + j]; }
template <int WHICH> __device__ __forceinline__ void phase_rows(const Params& p, LAS unsigned char* lds) {
    LAS float* vA = (LAS float*)lds;
    LAS float* vB = vA + 2048;
    LAS float* vG = vB + 2048;
    LAS float* vH = vG + 2048;
    const int tid = threadIdx.x, wid = __builtin_amdgcn_readfirstlane(tid >> 6), lane = tid & 63;
    bf16_t* HB = (bf16_t*)(p.ws + OFF_HB);
    for (int chunk = blockIdx.x; chunk < NTOK / 64; chunk += gridDim.x) {
        const int row0 = chunk * 64, b = row0 >> 12;
        __syncthreads();
        for (int j = tid; j < 2048; j += 512) {
            if (WHICH == 0) { vA[j] = p.ln_pre_g[j] * (1.f + mod_val(p, 0, b, 2048 + j)); vB[j] = mod_val(p, 0, b, j); }
            if (WHICH == 1) { vG[j] = mod_val(p, 0, b, 4096 + j) * p.ln_post_g[j]; vA[j] = p.ln_pre_g[2048 + j] * (1.f + mod_val(p, 1, b, 2048 + j)); vB[j] = mod_val(p, 1, b, j); }
            if (WHICH == 2) { vG[j] = mod_val(p, 0, b, 4096 + j) * p.ln_post_g[j]; vH[j] = mod_val(p, 1, b, 4096 + j) * p.ln_post_g[2048 + j]; }
        }
        __syncthreads();
        for (int r = wid; r < 64; r += 8) {
            const size_t row = (size_t)(row0 + r);
            f32x4 xv[8];
#pragma unroll
            for (int j = 0; j < 8; ++j) xv[j] = (WHICH != 2) ? __builtin_nontemporal_load((const f32x4*)(p.x + row * 2048 + (lane + 64 * j) * 4)) : *(const f32x4*)(p.x + row * 2048 + (lane + 64 * j) * 4);
#pragma unroll
            for (int pass = 0; pass < 2; ++pass) {
                if (WHICH == 0 || (WHICH == 1 && pass == 1)) continue;
                const bf16_t* Y = (const bf16_t*)(p.ws + (pass == 0 ? OFF_Y0 : OFF_Y1));
                LAS float* gvec = (pass == 0) ? vG : vH;
                f32x4 yv[8]; float ssy = 0.f;
#pragma unroll
                for (int j = 0; j < 8; ++j) { const u32x2 w = (WHICH == 1) ? __builtin_nontemporal_load((const u32x2*)(Y + row * 2048 + (lane + 64 * j) * 4)) : *(const u32x2*)(Y + row * 2048 + (lane + 64 * j) * 4);
                    yv[j][0] = __uint_as_float(w.x << 16); yv[j][1] = __uint_as_float(w.x & 0xffff0000u); yv[j][2] = __uint_as_float(w.y << 16); yv[j][3] = __uint_as_float(w.y & 0xffff0000u);
                    ssy += yv[j][0] * yv[j][0] + yv[j][1] * yv[j][1] + yv[j][2] * yv[j][2] + yv[j][3] * yv[j][3]; }
                const float ry = rsqrtf(wave_sum(ssy) * (1.f / 2048.f) + EPS);
#pragma unroll
                for (int j = 0; j < 8; ++j) { const f32x4 gv = *(const LAS f32x4*)(gvec + (lane + 64 * j) * 4);
#pragma unroll
                    for (int e = 0; e < 4; ++e) xv[j][e] += gv[e] * (yv[j][e] * ry); }
            }
            if (WHICH == 2) {
#pragma unroll
                for (int j = 0; j < 8; ++j) *(f32x4*)(p.out + row * 2048 + (lane + 64 * j) * 4) = xv[j];
            } else {
                float ss = 0.f;
#pragma unroll
                for (int j = 0; j < 8; ++j) ss += xv[j][0] * xv[j][0] + xv[j][1] * xv[j][1] + xv[j][2] * xv[j][2] + xv[j][3] * xv[j][3];
                const float rx = rsqrtf(wave_sum(ss) * (1.f / 2048.f) + EPS);
#pragma unroll
                for (int j = 0; j < 8; ++j) { const f32x4 av = *(const LAS f32x4*)(vA + (lane + 64 * j) * 4), bv = *(const LAS f32x4*)(vB + (lane + 64 * j) * 4);
                    u32x2 w; w.x = cvt_pk_bf16(xv[j][0] * rx * av[0] + bv[0], xv[j][1] * rx * av[1] + bv[1]); w.y = cvt_pk_bf16(xv[j][2] * rx * av[2] + bv[2], xv[j][3] * rx * av[3] + bv[3]);
                    *(u32x2*)(HB + row * 2048 + (lane + 64 * j) * 4) = w; }
            }
        }
    }
}

__device__ __forceinline__ void sgu_item(const Params& p, LAS unsigned char* lds, int b, int n, int h) {
    LAS bf16_t* Ws = (LAS bf16_t*)lds;
    LAS bf16_t* Vn = Ws + 128 * 136;
    const int tid = threadIdx.x, wid = __builtin_amdgcn_readfirstlane(tid >> 6), lane = tid & 63, fr = lane & 15, g = lane >> 4;
    const bf16_t* P = (const bf16_t*)(p.ws + OFF_PROJ);
    bf16_t* MIX = (bf16_t*)(p.ws + OFF_MIX);
    const size_t tok0 = (size_t)b * SEQ + (size_t)n * 128;
    __syncthreads();
    const float* Wg = p.sgu_w + (size_t)h * 16384;
#pragma unroll
    for (int i = 0; i < 8; ++i) { const int idx = tid + 512 * i, r = idx >> 5, c4 = (idx & 31) * 4;
        f32x4 w = *(const f32x4*)(Wg + r * 128 + c4);
        w[0] = (c4 + 0 <= r) ? w[0] : 0.f; w[1] = (c4 + 1 <= r) ? w[1] : 0.f; w[2] = (c4 + 2 <= r) ? w[2] : 0.f; w[3] = (c4 + 3 <= r) ? w[3] : 0.f;
        u32x2 o; o.x = cvt_pk_bf16(w[0], w[1]); o.y = cvt_pk_bf16(w[2], w[3]);
        *(LAS u32x2*)(Ws + r * 136 + c4) = o; }
    {
        const int s = tid >> 2, q4 = tid & 3;
        const bf16_t* src = P + (tok0 + s) * 7168 + 1024 + h * 128 + q4 * 32;
        bf16x8 v[4]; float ss = 0.f;
#pragma unroll
        for (int i = 0; i < 4; ++i) { v[i] = *(const bf16x8*)(src + 8 * i);
#pragma unroll
            for (int j = 0; j < 8; ++j) { const float f = bf2f((unsigned short)v[i][j]); ss += f * f; } }
        ss += __shfl_xor(ss, 1); ss += __shfl_xor(ss, 2);
        const float rn = rsqrtf(ss * (1.f / 128.f) + EPS);
#pragma unroll
        for (int i = 0; i < 4; ++i) { const int d0 = q4 * 32 + 8 * i; const f32x4 g0 = *(const f32x4*)(p.sgu_norm_g + h * 128 + d0), g1 = *(const f32x4*)(p.sgu_norm_g + h * 128 + d0 + 4);
            u32x4 o; o.x = cvt_pk_bf16(bf2f((unsigned short)v[i][0]) * rn * g0[0], bf2f((unsigned short)v[i][1]) * rn * g0[1]); o.y = cvt_pk_bf16(bf2f((unsigned short)v[i][2]) * rn * g0[2], bf2f((unsigned short)v[i][3]) * rn * g0[3]);
            o.z = cvt_pk_bf16(bf2f((unsigned short)v[i][4]) * rn * g1[0], bf2f((unsigned short)v[i][5]) * rn * g1[1]); o.w = cvt_pk_bf16(bf2f((unsigned short)v[i][6]) * rn * g1[2], bf2f((unsigned short)v[i][7]) * rn * g1[3]);
            *(LAS u32x4*)(Vn + s * 144 + d0) = o; }
    }
    const int t = 16 * wid + fr; const size_t tok = tok0 + t; const float bs = p.sgu_b[h * 128 + t];
    u32x2 gur[8], szr[8];
#pragma unroll
    for (int db = 0; db < 8; ++db) { const int col = h * 128 + 16 * db + 4 * g; gur[db] = *(const u32x2*)(P + tok * 7168 + col); szr[db] = *(const u32x2*)(P + tok * 7168 + 2048 + col); }
    __syncthreads();
    const int nks = (wid >> 1) + 1;
    f32x4 acc[8];
#pragma unroll
    for (int db = 0; db < 8; ++db) acc[db] = (f32x4){0.f, 0.f, 0.f, 0.f};
#pragma unroll
    for (int ks = 0; ks < 4; ++ks) {
        if (ks < nks) {
            const LAS bf16_t* wp = Ws + (16 * wid + fr) * 136 + 32 * ks + 4 * g;
            const u32x2 wlo = *(const LAS u32x2*)wp, whi = *(const LAS u32x2*)(wp + 16);
            u32x4 wv; wv.x = wlo.x; wv.y = wlo.y; wv.z = whi.x; wv.w = whi.y;
            const bf16x8 bfrag = __builtin_bit_cast(bf16x8, wv);
#pragma unroll
            for (int db = 0; db < 8; ++db) { const LAS bf16_t* vb = Vn + (32 * ks + 4 * g + (fr >> 2)) * 144 + 16 * db + 4 * (fr & 3);
                acc[db] = mfma16(cat4(lds_tr16(vb), lds_tr16(vb + 16 * 144)), bfrag, acc[db]); }
        }
    }
#pragma unroll
    for (int db = 0; db < 8; ++db) { const int col = h * 128 + 16 * db + 4 * g;
        const u32x2 gu = gur[db], sz = szr[db];
        const float o0 = __uint_as_float(gu.x << 16) * (acc[db][0] + bs) * __uint_as_float(sz.x << 16);
        const float o1 = __uint_as_float(gu.x & 0xffff0000u) * (acc[db][1] + bs) * __uint_as_float(sz.x & 0xffff0000u);
        const float o2 = __uint_as_float(gu.y << 16) * (acc[db][2] + bs) * __uint_as_float(sz.y << 16);
        const float o3 = __uint_as_float(gu.y & 0xffff0000u) * (acc[db][3] + bs) * __uint_as_float(sz.y & 0xffff0000u);
        u32x2 w; w.x = cvt_pk_bf16(o0, o1); w.y = cvt_pk_bf16(o2, o3);
        *(u32x2*)(MIX + tok * 2048 + col) = w; }
}

__device__ __forceinline__ void attn_wave_item(const Params& p, LAS unsigned char* wl, int b, int h, int qblk) {
    LAS bf16_t* Kw = (LAS bf16_t*)wl;
    LAS bf16_t* Vw = Kw + 32 * 144;
    const int lane = threadIdx.x & 63, fr = lane & 15, g = lane >> 4;
    const bf16_t* P = (const bf16_t*)(p.ws + OFF_PROJ);
    bf16_t* MIX = (bf16_t*)(p.ws + OFF_MIX);
    const size_t tokb = (size_t)b * SEQ;
    const int qrow0 = qblk * 32 + fr;
    bf16x8 qf[2][4];
#pragma unroll
    for (int c = 0; c < 2; ++c) { const bf16_t* qp = P + (tokb + qrow0 + 16 * c) * 7168 + 3072 + h * 128 + 8 * g;
#pragma unroll
      for (int ks = 0; ks < 4; ++ks) qf[c][ks] = *(const bf16x8*)(qp + 32 * ks); }
    f32x4 oacc[2][8];
#pragma unroll
    for (int c = 0; c < 2; ++c)
#pragma unroll
        for (int db = 0; db < 8; ++db) oacc[c][db] = (f32x4){0.f, 0.f, 0.f, 0.f};
    float carry0 = 1.f, carry1 = 1.f;
    const int lrow = lane >> 4, ld8 = (lane & 15) * 8;
    bf16x8 kreg[8], vreg[8];
#define AW_LOAD(kt_) do { const bf16_t* base_ = P + (tokb + (size_t)(kt_) * 32 + lrow) * 7168 + h * 128 + ld8; \
        _Pragma("unroll") for (int i_ = 0; i_ < 8; ++i_) { kreg[i_] = *(const bf16x8*)(base_ + (size_t)(4 * i_) * 7168 + 4096); vreg[i_] = *(const bf16x8*)(base_ + (size_t)(4 * i_) * 7168 + 5120); } } while (0)
    AW_LOAD(qblk);
    for (int kt = qblk; kt >= 0; --kt) {
#pragma unroll
        for (int i = 0; i < 8; ++i) { *(LAS bf16x8*)(Kw + (lrow + 4 * i) * 144 + ld8) = kreg[i]; *(LAS bf16x8*)(Vw + (lrow + 4 * i) * 144 + ld8) = vreg[i]; }
        if (kt > 0) AW_LOAD(kt - 1);
        wave_lds_sync();
        bf16x8 pf[2];
#pragma unroll
        for (int c = 0; c < 2; ++c) { const int qrow = qrow0 + 16 * c; float cy = c ? carry1 : carry0;
            f32x4 s0 = (f32x4){0.f, 0.f, 0.f, 0.f}, s1 = (f32x4){0.f, 0.f, 0.f, 0.f};
#pragma unroll
            for (int ks = 0; ks < 4; ++ks) { s0 = mfma16(*(const LAS bf16x8*)(Kw + fr * 144 + 8 * g + 32 * ks), qf[c][ks], s0); s1 = mfma16(*(const LAS bf16x8*)(Kw + (16 + fr) * 144 + 8 * g + 32 * ks), qf[c][ks], s1); }
            float w[2][4];
#pragma unroll
            for (int kk = 0; kk < 2; ++kk) { const int kb = 1 - kk; const f32x4 sv = kb ? s1 : s0;
                float be[4], kp[4];
#pragma unroll
                for (int r = 0; r < 4; ++r) { const float z = sv[r]; const int kpos = kt * 32 + 16 * kb + 4 * g + r;
                    const float e = __builtin_amdgcn_exp2f(fminf(z, 80.f)); const float k1 = __builtin_amdgcn_rcpf(1.f + e);
                    const bool ok = kpos < qrow; kp[r] = ok ? k1 : 1.f; be[r] = ok ? e * k1 : 0.f; }
                const float x2 = kp[3], x1 = x2 * kp[2], x0 = x1 * kp[1], tot = x0 * kp[0];
                const float p16 = __shfl_xor(tot, 16), a1 = tot * p16, po = __shfl_xor(a1, 32);
                const float base = cy * ((g & 1) ? 1.f : p16) * ((g < 2) ? po : 1.f);
                w[kb][0] = be[0] * (base * x0); w[kb][1] = be[1] * (base * x1); w[kb][2] = be[2] * (base * x2); w[kb][3] = be[3] * base;
                cy *= a1 * po;
            }
            if (c) carry1 = cy; else carry0 = cy;
            u32x4 pw; pw.x = cvt_pk_bf16(w[0][0], w[0][1]); pw.y = cvt_pk_bf16(w[0][2], w[0][3]); pw.z = cvt_pk_bf16(w[1][0], w[1][1]); pw.w = cvt_pk_bf16(w[1][2], w[1][3]);
            pf[c] = __builtin_bit_cast(bf16x8, pw);
        }
#pragma unroll
        for (int db = 0; db < 8; ++db) { const LAS bf16_t* vb = Vw + (4 * g + (fr >> 2)) * 144 + 16 * db + 4 * (fr & 3);
            const bf16x8 av = cat4(lds_tr16(vb), lds_tr16(vb + 16 * 144));
            oacc[0][db] = mfma16(av, pf[0], oacc[0][db]); oacc[1][db] = mfma16(av, pf[1], oacc[1][db]); }
        if (__all((carry0 == 0.f) && (carry1 == 0.f))) break;
        wave_lds_sync();
    }
#undef AW_LOAD
#pragma unroll
    for (int c = 0; c < 2; ++c) { const size_t tok = tokb + qrow0 + 16 * c;
#pragma unroll
        for (int db = 0; db < 8; ++db) { const int col = h * 128 + 16 * db + 4 * g;
            const u32x2 sz = *(const u32x2*)(P + tok * 7168 + 6144 + col);
            u32x2 w; w.x = cvt_pk_bf16(oacc[c][db][0] * __uint_as_float(sz.x << 16), oacc[c][db][1] * __uint_as_float(sz.x & 0xffff0000u));
            w.y = cvt_pk_bf16(oacc[c][db][2] * __uint_as_float(sz.y << 16), oacc[c][db][3] * __uint_as_float(sz.y & 0xffff0000u));
            *(u32x2*)(MIX + tok * 2048 + 1024 + col) = w; } }
}

__device__ __forceinline__ void phase_mixers(const Params& p, LAS unsigned char* lds) {
    const int G = gridDim.x, wid = __builtin_amdgcn_readfirstlane(threadIdx.x >> 6);
    const int vcu = (G == 256) ? (int)((blockIdx.x & 7) * 32 + (blockIdx.x >> 3)) : (int)blockIdx.x;
    for (int rp_ = 0; rp_ < ATT_REP; ++rp_)
    for (int i = vcu; i < 512; i += G) { const int bh = i >> 4, qb = i & 15; attn_wave_item(p, lds + wid * 18432, bh >> 3, bh & 7, qb * 8 + wid); }
    for (int rp_ = 0; rp_ < SGU_REP; ++rp_)
    for (int i = blockIdx.x; i < 1024; i += G) sgu_item(p, lds, i >> 8, (i >> 3) & 31, i & 7);
}

__device__ __forceinline__ void ssm_coef(const Params& p, int grp, int pp, float& are, float& aim, float& cre, float& cim) {
    const float dt = expf(p.log_dt[grp]); const float lr = p.lam_re[grp * 64 + pp], li = p.lam_im[grp * 64 + pp];
    const float mag = expf(lr * dt); are = mag * cosf(li * dt); aim = mag * sinf(li * dt);
    const float den = lr * lr + li * li, nr = are - 1.f;
    cre = (nr * lr + aim * li) / den; cim = (aim * lr - nr * li) / den;
}
__device__ __forceinline__ void ssm_item(const Params& p, LAS unsigned char* lds, int b, int grp) {
    LAS float* aTab = (LAS float*)lds;
    LAS bf16_t* BmN = (LAS bf16_t*)(lds + 1024);
    LAS bf16_t* CmT = (LAS bf16_t*)(lds + 5376);
    LAS float* S = (LAS float*)(lds + 9728);
    LAS bf16_t* Kt = (LAS bf16_t*)(lds + 42496);
    LAS float* AP = (LAS float*)(lds + 75776);
    const int tid = threadIdx.x, wid = __builtin_amdgcn_readfirstlane(tid >> 6), lane = tid & 63, fr = lane & 15, g = lane >> 4;
    __syncthreads();
    if (tid < 64) { float are, aim, cre, cim; ssm_coef(p, grp, tid, are, aim, cre, cim); aTab[tid] = are; aTab[64 + tid] = aim;
        float pr = are, pi = aim;
#pragma unroll
        for (int i = 0; i < 6; ++i) { const float nr2 = pr * pr - pi * pi, ni2 = 2.f * pr * pi; pr = nr2; pi = ni2; }
        aTab[128 + tid] = pr; aTab[192 + tid] = pi; }
    if (tid < 128) ((LAS unsigned*)Kt)[tid] = 0u;
#pragma unroll
    for (int i = 0; i < 2; ++i) { const int idx = tid + 512 * i, pp = idx >> 4, c = idx & 15; float are, aim, cre, cim; ssm_coef(p, grp, pp, are, aim, cre, cim);
        const float br = p.b_re[((size_t)grp * 64 + pp) * 16 + c], bi = p.b_im[((size_t)grp * 64 + pp) * 16 + c];
        BmN[c * 136 + 2 * pp] = f2bf(cre * br - cim * bi); BmN[c * 136 + 2 * pp + 1] = f2bf(cre * bi + cim * br); }
#pragma unroll
    for (int i = 0; i < 2; ++i) { const int idx = tid + 512 * i, c = idx >> 6, pp = idx & 63;
        CmT[c * 136 + 2 * pp] = f2bf(p.c_re[((size_t)grp * 16 + c) * 64 + pp]); CmT[c * 136 + 2 * pp + 1] = f2bf(-p.c_im[((size_t)grp * 16 + c) * 64 + pp]); }
    {
        const int pp = tid & 63, j8 = tid >> 6; float are, aim, cre, cim; ssm_coef(p, grp, pp, are, aim, cre, cim);
        float cr = 1.f, ci = 0.f;
        for (int i = 0; i < 8 * j8; ++i) { const float nr = cr * are - ci * aim, ni = cr * aim + ci * are; cr = nr; ci = ni; }
        if (j8 == 0) { AP[2 * pp] = 1.f; AP[2 * pp + 1] = 0.f; }
#pragma unroll
        for (int i = 1; i <= 8; ++i) { const float nr = cr * are - ci * aim, ni = cr * aim + ci * are; cr = nr; ci = ni; AP[((8 * j8 + i) * 64 + pp) * 2] = cr; AP[((8 * j8 + i) * 64 + pp) * 2 + 1] = ci; }
    }
    __syncthreads();
    bf16x8 cfr[4];
#pragma unroll
    for (int ks = 0; ks < 4; ++ks) cfr[ks] = *(const LAS bf16x8*)(CmT + fr * 136 + 8 * g + 32 * ks);
    const bf16_t* U = (const bf16_t*)(p.ws + OFF_UG) + (size_t)(b * 64 + grp) * 4096 * 16;
    bf16_t* Gout = (bf16_t*)(p.ws + OFF_MIX) + (size_t)b * SEQ * 1024 + grp * 16;
    const int th = g >> 1, c0 = 8 * (g & 1);
    const int cbw = wid & 3, hh = wid >> 2;
    {
        for (int qh = 0; qh < 2; ++qh) {
        float X[2][8], Y[2][8], a2r[2], a2i[2], apr[2], api[2];
#pragma unroll
        for (int q = 0; q < 2; ++q) { const int pl = 8 * (4 * hh + 2 * qh + q) + (fr >> 1), ri = fr & 1;
            const float are_l = aTab[pl], aim_l = aTab[64 + pl];
#pragma unroll
            for (int j = 0; j < 8; ++j) { const float bbre = bf2f(BmN[(c0 + j) * 136 + 2 * pl]), bbim = bf2f(BmN[(c0 + j) * 136 + 2 * pl + 1]);
                X[q][j] = ri ? bbim : bbre; Y[q][j] = ri ? bbre : -bbim; }
            a2r[q] = are_l * are_l - aim_l * aim_l; a2i[q] = 2.f * are_l * aim_l;
            apr[q] = th ? 1.f : are_l; api[q] = th ? 0.f : aim_l; }
        f32x4 sacc[2];
#pragma unroll
        for (int q = 0; q < 2; ++q) sacc[q] = (f32x4){0.f, 0.f, 0.f, 0.f};
#pragma unroll 4
        for (int ks = 31; ks >= 0; --ks) {
            const bf16x8 bf = *(const bf16x8*)(U + (size_t)(64 * (16 * cbw + fr) + 2 * ks + th) * 16 + c0);
#pragma unroll
            for (int q = 0; q < 2; ++q) {
                u32x4 aw; aw.x = cvt_pk_bf16(apr[q] * X[q][0] + api[q] * Y[q][0], apr[q] * X[q][1] + api[q] * Y[q][1]); aw.y = cvt_pk_bf16(apr[q] * X[q][2] + api[q] * Y[q][2], apr[q] * X[q][3] + api[q] * Y[q][3]);
                aw.z = cvt_pk_bf16(apr[q] * X[q][4] + api[q] * Y[q][4], apr[q] * X[q][5] + api[q] * Y[q][5]); aw.w = cvt_pk_bf16(apr[q] * X[q][6] + api[q] * Y[q][6], apr[q] * X[q][7] + api[q] * Y[q][7]);
                sacc[q] = mfma16(__builtin_bit_cast(bf16x8, aw), bf, sacc[q]);
                const float nr = apr[q] * a2r[q] - api[q] * a2i[q], ni = apr[q] * a2i[q] + api[q] * a2r[q]; apr[q] = nr; api[q] = ni; }
        }
#pragma unroll
        for (int q = 0; q < 2; ++q) *(LAS f32x4*)(S + (16 * cbw + fr) * 128 + 16 * (4 * hh + 2 * qh + q) + 4 * g) = sacc[q];
        }
    }
    {
        float cr[4][4], ci[4][4];
#pragma unroll
        for (int ks = 0; ks < 4; ++ks)
#pragma unroll
            for (int jp = 0; jp < 4; ++jp) { const int pp = 16 * ks + 4 * g + jp; cr[ks][jp] = p.c_re[((size_t)grp * 16 + fr) * 64 + pp]; ci[ks][jp] = p.c_im[((size_t)grp * 16 + fr) * 64 + pp]; }
        bf16x8 bmf[4];
#pragma unroll
        for (int ks = 0; ks < 4; ++ks) bmf[ks] = *(const LAS bf16x8*)(BmN + fr * 136 + 8 * g + 32 * ks);
        for (int li = 0; li < 8; ++li) { const int l = 8 * wid + li;
            f32x4 kacc = (f32x4){0.f, 0.f, 0.f, 0.f};
#pragma unroll
            for (int ks = 0; ks < 4; ++ks) { const LAS f32x4* ap = (const LAS f32x4*)(AP + (l * 64 + 16 * ks + 4 * g) * 2);
                const f32x4 p01 = ap[0], p23 = ap[1];
                const float pr[4] = {p01[0], p01[2], p23[0], p23[2]}, pi[4] = {p01[1], p01[3], p23[1], p23[3]};
                float v[8];
#pragma unroll
                for (int jp = 0; jp < 4; ++jp) { v[2 * jp] = cr[ks][jp] * pr[jp] - ci[ks][jp] * pi[jp]; v[2 * jp + 1] = -(cr[ks][jp] * pi[jp] + ci[ks][jp] * pr[jp]); }
                u32x4 aw; aw.x = cvt_pk_bf16(v[0], v[1]); aw.y = cvt_pk_bf16(v[2], v[3]); aw.z = cvt_pk_bf16(v[4], v[5]); aw.w = cvt_pk_bf16(v[6], v[7]);
                kacc = mfma16(__builtin_bit_cast(bf16x8, aw), bmf[ks], kacc); }
#pragma unroll
            for (int q = 0; q < 4; ++q) Kt[(l + 1) * 256 + (4 * g + q) * 16 + fr] = f2bf(kacc[q]);
        }
    }
    __syncthreads();
    if (wid == 0) { const float Ar = aTab[128 + lane], Ai = aTab[192 + lane]; float rre = 0.f, rim = 0.f;
        for (int ch = 0; ch < 64; ++ch) { const f32x2v sv = *(const LAS f32x2v*)(S + ch * 128 + 2 * lane);
            f32x2v o; o.x = rre; o.y = rim; *(LAS f32x2v*)(S + ch * 128 + 2 * lane) = o;
            const float nre = Ar * rre - Ai * rim + sv.x, nim = Ar * rim + Ai * rre + sv.y; rre = nre; rim = nim; } }
    __syncthreads();
    f32x4 dsk;
#pragma unroll
    for (int q = 0; q < 4; ++q) dsk[q] = p.d_skip[grp * 16 + 4 * g + q];
    f32x4 h01[4], h23[4];
#pragma unroll
    for (int ks = 0; ks < 4; ++ks) { const LAS f32x4* hp = (const LAS f32x4*)(S + (16 * cbw + fr) * 128 + 32 * ks + 8 * g); h01[ks] = hp[0]; h23[ks] = hp[1]; }
    for (int g4 = 0; g4 < 4; ++g4) {
        f32x4 acc[8];
#pragma unroll
        for (int ii = 0; ii < 8; ++ii) acc[ii] = (f32x4){0.f, 0.f, 0.f, 0.f};
#pragma unroll
        for (int ii = 0; ii < 8; ++ii) { const int t = 2 * (8 * g4 + ii) + hh;
#pragma unroll
            for (int ks = 0; ks < 4; ++ks) { const LAS f32x4* ap = (const LAS f32x4*)(AP + ((t + 1) * 64 + 16 * ks + 4 * g) * 2);
                const f32x4 p01 = ap[0], p23 = ap[1];
                u32x4 hw;
                hw.x = cvt_pk_bf16(p01[0] * h01[ks][0] - p01[1] * h01[ks][1], p01[0] * h01[ks][1] + p01[1] * h01[ks][0]);
                hw.y = cvt_pk_bf16(p01[2] * h01[ks][2] - p01[3] * h01[ks][3], p01[2] * h01[ks][3] + p01[3] * h01[ks][2]);
                hw.z = cvt_pk_bf16(p23[0] * h23[ks][0] - p23[1] * h23[ks][1], p23[0] * h23[ks][1] + p23[1] * h23[ks][0]);
                hw.w = cvt_pk_bf16(p23[2] * h23[ks][2] - p23[3] * h23[ks][3], p23[2] * h23[ks][3] + p23[3] * h23[ks][2]);
                acc[ii] = mfma16(cfr[ks], __builtin_bit_cast(bf16x8, hw), acc[ii]); } }
        const int nks = 8 * g4 + 8;
#pragma unroll 2
        for (int ks2 = 0; ks2 < nks; ++ks2) {
            const bf16x8 ub = *(const bf16x8*)(U + (size_t)(64 * (16 * cbw + fr) + 2 * ks2 + th) * 16 + c0);
#pragma unroll
            for (int ii = 0; ii < 8; ++ii) { const int t = 2 * (8 * g4 + ii) + hh;
                int li = t - (2 * ks2 + th) + 1; li = li < 0 ? 0 : li;
                const bf16x8 kf = *(const LAS bf16x8*)(Kt + li * 256 + fr * 16 + c0);
                acc[ii] = mfma16(kf, ub, acc[ii]); }
        }
#pragma unroll
        for (int ii = 0; ii < 8; ++ii) { const int t = 2 * (8 * g4 + ii) + hh; const size_t tok = (size_t)(64 * (16 * cbw + fr) + t);
            const u32x2 u4 = *(const u32x2*)(U + tok * 16 + 4 * g);
            const float o0 = gelu_f(acc[ii][0] + dsk[0] * __uint_as_float(u4.x << 16)), o1 = gelu_f(acc[ii][1] + dsk[1] * __uint_as_float(u4.x & 0xffff0000u));
            const float o2 = gelu_f(acc[ii][2] + dsk[2] * __uint_as_float(u4.y << 16)), o3 = gelu_f(acc[ii][3] + dsk[3] * __uint_as_float(u4.y & 0xffff0000u));
            u32x2 w; w.x = cvt_pk_bf16(o0, o1); w.y = cvt_pk_bf16(o2, o3);
            *(u32x2*)(Gout + tok * 1024 + 4 * g) = w; }
    }
}

#define XB_TMO      128
#define XB_XCNT(j)  (256  + 64 * (j))
#define XB_XSUB(j)  (1280 + 64 * (j))
#define XB_XGEN(j)  (2304 + 64 * (j))
#define XB_TOP      3328
#define XB_TOPGEN   3392
#define XCD_BAR_WORDS 3456
#define XB_SPIN_CAP (1u << 18)

__device__ __forceinline__ unsigned xb_ld(unsigned* p)              { return __hip_atomic_load(p, __ATOMIC_RELAXED, __HIP_MEMORY_SCOPE_AGENT); }
__device__ __forceinline__ unsigned xb_add(unsigned* p, unsigned v) { return __hip_atomic_fetch_add(p, v, __ATOMIC_RELAXED, __HIP_MEMORY_SCOPE_AGENT); }
__device__ __forceinline__ unsigned xb_xcc_id() { return (unsigned)__builtin_amdgcn_s_getreg((3 << 11) | 20) & 0xFu; }
#define XB_SPIN(cond, bar) do { unsigned _sp = 0; while (cond) { __builtin_amdgcn_s_sleep(1); \
    if ((++_sp & 255u) == 0u) { if (xb_ld(&(bar)[XB_TMO])) break; if (_sp > XB_SPIN_CAP) { atomicAdd(&(bar)[XB_TMO], 1u); break; } } } } while (0)

struct XcdBarrier {
    unsigned* bar; unsigned x;
    volatile LAS unsigned* st;
};

__device__ __forceinline__ XcdBarrier xcd_barrier_post(unsigned* bar, volatile LAS unsigned* st) {
    XcdBarrier b; b.bar = bar; b.x = xb_xcc_id(); b.st = st;
    if (threadIdx.x == 0) (void)xb_add(&bar[XB_XCNT(b.x)], 1u);
    return b;
}
__device__ __forceinline__ void xcd_barrier_complete(unsigned* bar, unsigned x, unsigned& nloc, unsigned& nx) {
    const unsigned G = gridDim.x * gridDim.y * gridDim.z;
    unsigned sum, cnt, mine, sp = 0u;
    for (;;) {
        sum = 0u; cnt = 0u; mine = 0u;
#pragma unroll
        for (unsigned j = 0; j < 16; ++j) { const unsigned c = xb_ld(&bar[XB_XCNT(j)]); sum += c; cnt += (c > 0u) ? 1u : 0u; mine = (j == x) ? c : mine; }
        if (sum == G) break;
        __builtin_amdgcn_s_sleep(1);
        if ((++sp & 255u) == 0u) { if (xb_ld(&bar[XB_TMO])) break; if (sp > XB_SPIN_CAP) { atomicAdd(&bar[XB_TMO], 1u); break; } }
    }
    nloc = mine > 0u ? mine : 1u; nx = cnt > 0u ? cnt : 1u;
}

__device__ __forceinline__ void xcd_barrier(const XcdBarrier& b) {
    asm volatile("s_waitcnt vmcnt(0)" ::: "memory");
    __syncthreads();
    if (threadIdx.x == 0) {
        unsigned* bar = b.bar;
        __builtin_amdgcn_s_waitcnt(0);
        unsigned nloc = b.st[0], nx = b.st[1];
        if (nloc == 0u) { xcd_barrier_complete(bar, b.x, nloc, nx); b.st[0] = nloc; b.st[1] = nx; }
        const unsigned old = xb_add(&bar[XB_XSUB(b.x)], 1u);
        const unsigned gen = old / nloc;
        if (old + 1u == (gen + 1u) * nloc) {
            __builtin_amdgcn_fence(__ATOMIC_RELEASE, "agent");
            asm volatile("s_waitcnt vmcnt(0)" ::: "memory");
            const unsigned og = xb_add(&bar[XB_TOP], 1u);
            const unsigned tg = og / nx;
            if (og + 1u == (tg + 1u) * nx) xb_add(&bar[XB_TOPGEN], 1u);
            else XB_SPIN(xb_ld(&bar[XB_TOPGEN]) == tg, bar);
            __builtin_amdgcn_fence(__ATOMIC_ACQUIRE, "agent");
            xb_add(&bar[XB_XGEN(b.x)], 1u);
            asm volatile("s_waitcnt vmcnt(0)" ::: "memory");
        } else {
            XB_SPIN(xb_ld(&bar[XB_XGEN(b.x)]) == gen, bar);
            __builtin_amdgcn_fence(__ATOMIC_ACQUIRE, "agent");
            asm volatile("s_waitcnt vmcnt(0)" ::: "memory");
        }
    }
    __syncthreads();
}


template <int MODE> __device__ __forceinline__ void run_gemm(unsigned char* ws_, LAS unsigned char* lds, const bf16_t* A, const bf16_t* Bt, int N, int K, bf16_t* O, int ldc, const float* bias, const bf16_t* Gp, const bf16_t* UZp) {
    pg8::Gemm gm; gm.A = A; gm.Bt = Bt; gm.M = NTOK; gm.N = N; gm.K = K;
    pg8::StaticOrder S; S.init(NTOK, N, (int)gridDim.x, (int)blockIdx.x);
    pg8::EpiM<MODE> E; E.O = O; E.ldc = ldc; E.bias = bias; E.G = Gp; E.UZ = UZp; E.UG = (bf16_t*)(ws_ + OFF_UG); E.qscale = 0.12751743082459868f;
    pg8::gemm_phase<pg8::EpiM<MODE>, pg8::StaticOrder, GEMM_ALIGN, GEMM_SP2>(lds, gm, S, E);
}

#ifndef PHASE_MASK
#define PHASE_MASK 0x7ff
#endif
constexpr int N_PHASES = 11;
__global__ __launch_bounds__(512, 2) void mega_fwd(Params p, int ph_lo, int ph_hi) {
    extern __shared__ __attribute__((aligned(16))) unsigned char shm[];
    LAS unsigned char* lds = (LAS unsigned char*)shm;
    cg::grid_group grid = cg::this_grid();
    unsigned char* ws = p.ws;
    volatile LAS unsigned* xst = (volatile LAS unsigned*)(lds + LDS_BYTES - 16);
    if (threadIdx.x == 0) { xst[0] = 0u; xst[1] = 0u; }
    __syncthreads();
    const XcdBarrier xb = xcd_barrier_post((unsigned*)ws, xst);
    if (ph_lo < 0) grid.sync();
#ifndef REPEAT_MASK
#define REPEAT_MASK 0
#endif
#define PH_BEGIN(k) if (ph_lo <= (k) && (k) < ph_hi) { if ((k) > ph_lo) xcd_barrier(xb); for (int rep_ = 0; rep_ <= ((REPEAT_MASK >> (k)) & 1); ++rep_) {
#define PH_END }}
    PH_BEGIN(0) phase_mod(p, lds); PH_END
    PH_BEGIN(1) phase_rows<0>(p, lds); phase_transposes(p, lds); PH_END
    PH_BEGIN(2) run_gemm<0>(ws, lds, (const bf16_t*)(ws + OFF_HB), (const bf16_t*)(ws + OFF_W1T), 7168, 2048, (bf16_t*)(ws + OFF_PROJ), 7168, nullptr, nullptr, nullptr); PH_END
    PH_BEGIN(3) phase_mixers(p, lds); PH_END
    PH_BEGIN(4) run_gemm<1>(ws, lds, (const bf16_t*)(ws + OFF_MIX), (const bf16_t*)(ws + OFF_W2T), 2048, 2048, (bf16_t*)(ws + OFF_Y0), 2048, nullptr, nullptr, nullptr); PH_END
    PH_BEGIN(5) phase_rows<1>(p, lds); PH_END
    PH_BEGIN(6) run_gemm<2>(ws, lds, (const bf16_t*)(ws + OFF_HB), (const bf16_t*)(ws + OFF_W3T), 2048, 2048, (bf16_t*)(ws + OFF_UZ), 2048, nullptr, nullptr, nullptr); PH_END
    PH_BEGIN(7) for (int it = blockIdx.x; it < 256; it += gridDim.x) ssm_item(p, lds, it >> 6, it & 63); PH_END
    PH_BEGIN(8) run_gemm<3>(ws, lds, (const bf16_t*)(ws + OFF_MIX), (const bf16_t*)(ws + OFF_W4T), 1024, 1024, (bf16_t*)(ws + OFF_MIX) + (size_t)NTOK * 1024, 1024, p.b_glu, (const bf16_t*)(ws + OFF_MIX), (const bf16_t*)(ws + OFF_UZ)); PH_END
    PH_BEGIN(9) run_gemm<1>(ws, lds, (const bf16_t*)(ws + OFF_MIX) + (size_t)NTOK * 1024, (const bf16_t*)(ws + OFF_W5T), 2048, 1024, (bf16_t*)(ws + OFF_Y1), 2048, nullptr, nullptr, nullptr); PH_END
    PH_BEGIN(10) phase_rows<2>(p, lds); PH_END
}

extern "C" void kernel_launch(void* const* d_in, const int* in_sizes, int n_in, void* d_out, int out_size, void* d_ws, size_t ws_size, hipStream_t stream) {
    static int grid = 0;
    if (grid == 0) {
        if (n_in != 23 || out_size != NTOK * DM || ws_size < WS_END) { fprintf(stderr, "kernel_launch: unexpected shapes (n_in %d out %d ws %zu need %zu)\n", n_in, out_size, ws_size, (size_t)WS_END); grid = -1; return; }
        int dev = 0, cus = 0, per_cu = 0;
        (void)hipGetDevice(&dev); (void)hipDeviceGetAttribute(&cus, hipDeviceAttributeMultiprocessorCount, dev);
        if (hipFuncSetAttribute((const void*)mega_fwd, hipFuncAttributeMaxDynamicSharedMemorySize, LDS_BYTES) != hipSuccess) { fprintf(stderr, "kernel_launch: hipFuncSetAttribute failed\n"); grid = -1; return; }
        if (hipOccupancyMaxActiveBlocksPerMultiprocessor(&per_cu, (const void*)mega_fwd, 512, LDS_BYTES) != hipSuccess || per_cu < 1) { fprintf(stderr, "kernel_launch: occupancy query says %d\n", per_cu); per_cu = 1; }
        (void)hipGetLastError();
        grid = cus * 1;
        fprintf(stderr, "kernel_launch: grid %d (cus %d, per_cu %d)\n", grid, cus, per_cu);
    }
    if (grid < 0) return;
    if (hipMemsetAsync((char*)d_ws + OFF_BAR, 0, 16384, stream) != hipSuccess) { fprintf(stderr, "kernel_launch: memset of the barrier words failed\n"); return; }
    Params p{};
    const float** pp = (const float**)&p;
    for (int i = 0; i < 23; ++i) pp[i] = (const float*)d_in[i];
    p.out = (float*)d_out; p.ws = (unsigned char*)d_ws;
#if MULTI_LAUNCH
    for (int ph = 0; ph < N_PHASES; ++ph) {
        hipLaunchKernelGGL(mega_fwd, dim3(grid), dim3(512), LDS_BYTES, stream, p, ph, ph + 1);
    }
#else
    int lo = 0, hi = N_PHASES;
    void* args[] = {(void*)&p, (void*)&lo, (void*)&hi};
    hipError_t e = hipLaunchCooperativeKernel((const void*)mega_fwd, dim3(grid), dim3(512), args, LDS_BYTES, stream);
    if (e != hipSuccess) fprintf(stderr, "cooperative launch failed: %s (grid %d)\n", hipGetErrorString(e), grid);
#endif
}
```
